# Optimizing an MI355X kernel written in HIP

```python
import jax, jax.numpy as jnp
from jax import lax
import numpy as np

D_MODEL = 2048
BATCH = 4
SEQ = 2048
DEPTH = 2

N_B = DEPTH // 2
N_A = DEPTH - N_B
N_DENSE = (DEPTH + 1) // 2
N_MOE = DEPTH // 2
HEAD_DIM = 128
N_HEADS = D_MODEL // HEAD_DIM
CONV_WIDTH = 3
D_FF = 5632
N_EXPERTS = 8
TOP_K = 2
D_FF_EXPERT = 7168
PLE_DIM = 256
Q_BLOCK = 128
RMS_EPS = 1e-6
NEG_BIG = -1e30

kernel_name = "yoco_shortconv_fox_moe_ple"


def rms_norm(x, g):
    xf = x.astype(jnp.float32)
    y = xf * lax.rsqrt(jnp.mean(xf * xf, axis=-1, keepdims=True) + RMS_EPS) * g.astype(jnp.float32)
    return y.astype(x.dtype)


def short_conv_mixer(xn, w_in, w_dw, w_out):
    proj = xn @ w_in
    b_gate, c_gate, x_in = jnp.split(proj, 3, axis=-1)
    u = c_gate * x_in
    kern = w_dw[:, None, :].astype(u.dtype)
    conv = lax.conv_general_dilated(
        u, kern, window_strides=(1,), padding=[(CONV_WIDTH - 1, 0)],
        dimension_numbers=("NWC", "WIO", "NWC"), feature_group_count=D_MODEL)
    return (b_gate * conv) @ w_out


def shared_kv_side(h, kv_norm, w_kvf, b_f, k_norm):
    bsz, seq, _ = h.shape
    xs = rms_norm(h, kv_norm)
    kvf = xs @ w_kvf
    k = kvf[..., :D_MODEL].reshape(bsz, seq, N_HEADS, HEAD_DIM)
    v = kvf[..., D_MODEL:2 * D_MODEL].reshape(bsz, seq, N_HEADS, HEAD_DIM)
    f_logit = (kvf[..., 2 * D_MODEL:] + b_f).astype(jnp.float32)
    k = rms_norm(k, k_norm)
    c = jnp.cumsum(jax.nn.log_sigmoid(f_logit), axis=1)
    return (jnp.transpose(k, (0, 2, 1, 3)), jnp.transpose(v, (0, 2, 1, 3)),
            jnp.transpose(c, (0, 2, 1)))


def forgetting_attention(xn, k, v, c, w_q, q_norm, w_o):
    bsz, seq, _ = xn.shape
    n_blk = seq // Q_BLOCK
    q = rms_norm((xn @ w_q).reshape(bsz, seq, N_HEADS, HEAD_DIM), q_norm)
    q = jnp.transpose(q, (0, 2, 1, 3))
    q_blocks = jnp.moveaxis(q.reshape(bsz, N_HEADS, n_blk, Q_BLOCK, HEAD_DIM), 2, 0)
    c_blocks = jnp.moveaxis(c.reshape(bsz, N_HEADS, n_blk, Q_BLOCK), 2, 0)
    scale = HEAD_DIM ** -0.5
    k_pos = jnp.arange(seq)

    def one_block(args):
        qb, cqb, blk = args
        s = jnp.einsum("bhqd,bhkd->bhqk", qb, k).astype(jnp.float32) * scale
        s = s + cqb[..., :, None] - c[..., None, :]
        q_pos = blk * Q_BLOCK + jnp.arange(Q_BLOCK)
        s = jnp.where(k_pos[None, :] <= q_pos[:, None], s, NEG_BIG)
        a = jax.nn.softmax(s, axis=-1).astype(v.dtype)
        return jnp.einsum("bhqk,bhkd->bhqd", a, v)

    out = lax.map(one_block, (q_blocks, c_blocks, jnp.arange(n_blk)))
    out = jnp.moveaxis(out, 0, 2).reshape(bsz, N_HEADS, seq, HEAD_DIM)
    out = jnp.transpose(out, (0, 2, 1, 3)).reshape(bsz, seq, D_MODEL)
    return out @ w_o


def swiglu(xn, w_gu, w_down):
    g, u = jnp.split(xn @ w_gu, 2, axis=-1)
    return (jax.nn.silu(g) * u) @ w_down


def moe_swiglu(xn, w_router, w_gu, w_down):
    bsz, seq, d = xn.shape
    xf = xn.reshape(bsz * seq, d)
    logits = (xf @ w_router).astype(jnp.float32)
    top_v, top_i = lax.top_k(logits, TOP_K)
    top_w = jax.nn.softmax(top_v, axis=-1)
    gates = jnp.sum(jax.nn.one_hot(top_i, N_EXPERTS, dtype=jnp.float32) * top_w[..., None], axis=1)
    gates = gates.astype(xn.dtype)
    y = jnp.zeros_like(xf)
    for e in range(N_EXPERTS):
        y = y + gates[:, e:e + 1] * swiglu(xf, w_gu[e], w_down[e])
    return y.reshape(bsz, seq, d)


def setup_inputs(seed: int = 0) -> dict:
    key = jax.random.key(seed)
    ks = jax.random.split(key, 24)
    f32 = jnp.float32

    def nrm(k, shape, fan_in):
        return jax.random.normal(k, shape, f32) * (fan_in ** -0.5)

    def gain(k, shape):
        return 1.0 + 0.05 * jax.random.normal(k, shape, f32)

    D = D_MODEL
    return {
        "x": jax.random.normal(ks[0], (BATCH, SEQ, D), f32),
        "p": jax.random.normal(ks[1], (DEPTH, BATCH, SEQ, PLE_DIM), f32),
        "norm_mix": gain(ks[2], (DEPTH, D)),
        "norm_ffn": gain(ks[3], (DEPTH, D)),
        "norm_ple": gain(ks[4], (DEPTH, D)),
        "conv_in_w": nrm(ks[5], (N_A, D, 3 * D), D),
        "conv_dw": nrm(ks[6], (N_A, CONV_WIDTH, D), CONV_WIDTH),
        "conv_out_w": nrm(ks[7], (N_A, D, D), D),
        "kv_norm": gain(ks[8], (D,)),
        "w_kvf": nrm(ks[9], (D, 2 * D + N_HEADS), D),
        "b_f": 3.0 + 0.1 * jax.random.normal(ks[10], (N_HEADS,), f32),
        "k_norm": gain(ks[11], (HEAD_DIM,)),
        "attn_q_w": nrm(ks[12], (N_B, D, D), D),
        "q_norm": gain(ks[13], (N_B, HEAD_DIM)),
        "attn_out_w": nrm(ks[14], (N_B, D, D), D),
        "ffn_gu": nrm(ks[15], (N_DENSE, D, 2 * D_FF), D),
        "ffn_down": nrm(ks[16], (N_DENSE, D_FF, D), D_FF),
        "router_w": nrm(ks[17], (N_MOE, D, N_EXPERTS), D),
        "moe_gu": nrm(ks[18], (N_MOE, N_EXPERTS, D, 2 * D_FF_EXPERT), D),
        "moe_down": nrm(ks[19], (N_MOE, N_EXPERTS, D_FF_EXPERT, D), D_FF_EXPERT),
        "ple_up": nrm(ks[20], (DEPTH, PLE_DIM, D), PLE_DIM),
        "ple_gate": nrm(ks[21], (DEPTH, D, D), D),
    }


def reference(x, p, norm_mix, norm_ffn, norm_ple, conv_in_w, conv_dw, conv_out_w,
              kv_norm, w_kvf, b_f, k_norm, attn_q_w, q_norm, attn_out_w,
              ffn_gu, ffn_down, router_w, moe_gu, moe_down, ple_up, ple_gate):
    h = x
    shared = None
    for i in range(DEPTH):
        xn = rms_norm(h, norm_mix[i])
        if i < N_A:
            h = h + short_conv_mixer(xn, conv_in_w[i], conv_dw[i], conv_out_w[i])
        else:
            if i == N_A:
                shared = shared_kv_side(h, kv_norm, w_kvf, b_f, k_norm)
            j = i - N_A
            k_s, v_s, c_s = shared
            h = h + forgetting_attention(xn, k_s, v_s, c_s, attn_q_w[j], q_norm[j], attn_out_w[j])
        xn = rms_norm(h, norm_ffn[i])
        if i % 2 == 0:
            h = h + swiglu(xn, ffn_gu[i // 2], ffn_down[i // 2])
        else:
            h = h + moe_swiglu(xn, router_w[i // 2], moe_gu[i // 2], moe_down[i // 2])
        gate = jax.nn.sigmoid((rms_norm(h, norm_ple[i]) @ ple_gate[i]).astype(jnp.float32))
        h = h + gate.astype(h.dtype) * (p[i] @ ple_up[i])
    return h
```

```cpp
#include <hip/hip_runtime.h>
#include <hip/hip_bf16.h>
#include <cstdio>
#include <cstdint>

#define LAS __attribute__((address_space(3)))
#define GAS __attribute__((address_space(1)))

constexpr int DM = 2048, NB = 4, SEQ = 2048, T = NB * SEQ, NH = 16, HD = 128;
constexpr int DFF = 5632, NE = 8, DFE = 7168, PLE = 256;
constexpr float RMS_EPS = 1e-6f;
constexpr int MAXRT = 72;
constexpr int MAXROWS = MAXRT * 256;

namespace pg8 {
typedef unsigned short bf16_t;
typedef short bf16x8 __attribute__((ext_vector_type(8)));
typedef float f32x4 __attribute__((ext_vector_type(4)));
typedef unsigned u32x4 __attribute__((ext_vector_type(4)));
constexpr int BM = 256, BK = 64, HALF = 128, HTB = HALF * BK * 2, STAGE_BYTES = 8 * HTB, NXCD = 8, WGM = 8;

__host__ __device__ __forceinline__ int lds_byte(int r, int c) { const int st = (r >> 4) * 2 + (c >> 5), rr = r & 15, cc = c & 31, ob = rr * 64 + cc * 2; return st * 1024 + (ob ^ (((ob >> 9) & 1) << 5)); }
__host__ __device__ __forceinline__ void stage_rc(int b, int& R, int& C) { const int st = b / 1024, sb = b % 1024, swz = sb ^ (((sb >> 9) & 1) << 5); R = (st >> 1) * 16 + swz / 64; C = (st & 1) * 32 + (swz % 64) / 2; }
__host__ __device__ __forceinline__ int perm32(int rho) { const int n = rho >> 4, i = rho & 15; return 8 * (i >> 2) + 4 * n + (i & 3); }

struct Unit { int pm, pn, aux, par; };
struct Gemm { const bf16_t* A; const bf16_t* Bt; int M, N, K; };

struct RsNone { __device__ __forceinline__ void fill(const Unit&) const {} };
struct RsDirect { const float* src; LAS float* tab;
    __device__ __forceinline__ void fill(const Unit& u) const { const int t = threadIdx.x; if (t < 256) tab[u.par * 256 + t] = src[(size_t)u.pm * 256 + t]; } };
struct RsSlots { const float* slots; LAS float* tab;
    __device__ __forceinline__ void fill(const Unit& u) const {
        const int t = threadIdx.x, row = t >> 1, hf = t & 1; const f32x4* p = (const f32x4*)(slots + ((size_t)u.pm * 256 + row) * 32 + hf * 16);
        const f32x4 a = p[0], b = p[1], c = p[2], d = p[3];
        float s = ((a[0] + a[1]) + (a[2] + a[3])) + ((b[0] + b[1]) + (b[2] + b[3])) + ((c[0] + c[1]) + (c[2] + c[3])) + ((d[0] + d[1]) + (d[2] + d[3]));
        s += __shfl_xor(s, 1);
        if (hf == 0) tab[u.par * 256 + row] = 1.0f / sqrtf(s * (1.0f / DM) + RMS_EPS);
    } };

template <class RS> struct StaticOrder {
    int nM, nN, nwg, G, c; RS rs;
    __device__ __forceinline__ void init(int M, int N, int G_, int c_) { nM = M / BM; nN = N / BM; nwg = nM * nN; G = G_; c = c_; }
    __device__ __forceinline__ bool next(int i, Unit& u) const {
        const long L = (long)i * G + c; if (L >= nwg) return false;
        int wgid = (int)L; { const int q = nwg / NXCD, r = nwg % NXCD, xcd = wgid % NXCD, off = wgid / NXCD; wgid = (xcd < r ? xcd * (q + 1) : r * (q + 1) + (xcd - r) * q) + off; }
        const int nig = WGM * nN, gid = wgid / nig, fm = gid * WGM, gsz = (nM - fm) < WGM ? (nM - fm) : WGM;
        u.pm = fm + ((wgid % nig) % gsz); u.pn = (wgid % nig) / gsz; u.aux = u.pn; u.par = i & 1; return true;
    }
    __device__ __forceinline__ void a_ready(const Unit& u) const { rs.fill(u); }
    __device__ __forceinline__ void done(const Unit&) const {}
};
template <class RS> struct GroupedOrder {
    int rt[NE]; int NT, G, c, nwg; RS rs;
    __device__ __forceinline__ void init(const int* rts, int NT_, int G_, int c_) { int s = 0;
#pragma unroll
        for (int e = 0; e < NE; ++e) { rt[e] = rts[e]; s += rts[e]; } NT = NT_; G = G_; c = c_; nwg = s * NT_; }
    __device__ __forceinline__ bool next(int i, Unit& u) const {
        const long L = (long)i * G + c; if (L >= nwg) return false;
        int wgid = (int)L; { const int q = nwg / NXCD, r = nwg % NXCD, xcd = wgid % NXCD, off = wgid / NXCD; wgid = (xcd < r ? xcd * (q + 1) : r * (q + 1) + (xcd - r) * q) + off; }
        int e = 0, rbase = 0, w = wgid;
#pragma unroll
        for (int k = 0; k < NE - 1; ++k) { const int sz = rt[k] * NT; if (e == k && w >= sz) { w -= sz; rbase += rt[k]; e = k + 1; } }
        int rte = rt[0];
#pragma unroll
        for (int k = 1; k < NE; ++k) rte = (e == k) ? rt[k] : rte;
        const int pn = w / rte, rl = w - pn * rte;
        u.pm = rbase + rl; u.pn = e * NT + pn; u.aux = pn; u.par = i & 1; return true;
    }
    __device__ __forceinline__ void a_ready(const Unit& u) const { rs.fill(u); }
    __device__ __forceinline__ void done(const Unit&) const {}
};

__device__ __forceinline__ unsigned cvt_pk_bf16(float lo, float hi) { unsigned r; asm volatile("v_cvt_pk_bf16_f32 %0, %1, %2" : "=v"(r) : "v"(lo), "v"(hi)); return r; }
__device__ __forceinline__ u32x4 pack8(const f32x4 a, const f32x4 b) { u32x4 w; w.x = cvt_pk_bf16(a[0], a[1]); w.y = cvt_pk_bf16(a[2], a[3]); w.z = cvt_pk_bf16(b[0], b[1]); w.w = cvt_pk_bf16(b[2], b[3]); return w; }
__device__ __forceinline__ float bf_lo(unsigned w) { return __uint_as_float(w << 16); }
__device__ __forceinline__ float bf_hi(unsigned w) { return __uint_as_float(w & 0xffff0000u); }
__device__ __forceinline__ float sigmoidf_(float z) { return __builtin_amdgcn_rcpf(1.0f + __builtin_amdgcn_exp2f(-1.4426950408889634f * z)); }


template <bool SCALE> struct EpiBf16S {
    static constexpr bool PERM = true, AFTER_DRAIN = false;
    bf16_t* O; int ldc; int split_cols; size_t split_stride; const LAS float* tab;
    __device__ __forceinline__ void operator()(const f32x4 (&acc)[2][2][4][2], const Unit& u, int wr, int wc, int fr, int fq) const {
        int colt = u.aux * BM; bf16_t* base = O;
        if (split_cols) { const int t = colt / split_cols; base += (size_t)t * split_stride; colt -= t * split_cols; }
        const int col0 = colt + wc * 32 + 8 * fq;
#pragma unroll
        for (int ai = 0; ai < 2; ++ai)
#pragma unroll
            for (int m = 0; m < 4; ++m) { const int r = ai * HALF + wr * 64 + m * 16 + fr; const float s = SCALE ? tab[u.par * 256 + r] : 1.0f;
                bf16_t* rowp = base + (size_t)(u.pm * BM + r) * ldc + col0;
#pragma unroll
                for (int bj = 0; bj < 2; ++bj) *(u32x4*)(rowp + bj * HALF) = pack8(acc[ai][bj][m][0] * s, acc[ai][bj][m][1] * s); }
    }
};
template <int MODE, bool HASPLAIN> struct EpiPair {
    static constexpr bool PERM = true, AFTER_DRAIN = false;
    bf16_t* O; int ldc; int npair; bf16_t* O2; int ldc2; const LAS float* tab;
    __device__ __forceinline__ void operator()(const f32x4 (&acc)[2][2][4][2], const Unit& u, int wr, int wc, int fr, int fq) const {
        if (!HASPLAIN || u.aux < npair) {
            const int col0 = u.aux * HALF + wc * 32 + 8 * fq;
#pragma unroll
            for (int ai = 0; ai < 2; ++ai)
#pragma unroll
                for (int m = 0; m < 4; ++m) { const int r = ai * HALF + wr * 64 + m * 16 + fr; const float s = tab[u.par * 256 + r];
                    f32x4 o[2];
#pragma unroll
                    for (int n = 0; n < 2; ++n) { const f32x4 a = acc[ai][0][m][n] * s, b = acc[ai][1][m][n] * s;
                        if (MODE == 0) o[n] = a * b;
                        else {
#pragma unroll
                            for (int j = 0; j < 4; ++j) o[n][j] = a[j] * sigmoidf_(a[j]) * b[j]; } }
                    *(u32x4*)(O + (size_t)(u.pm * BM + r) * ldc + col0) = pack8(o[0], o[1]); }
        } else if (HASPLAIN) {
            const int col0 = (u.aux - npair) * BM + wc * 32 + 8 * fq;
#pragma unroll
            for (int ai = 0; ai < 2; ++ai)
#pragma unroll
                for (int m = 0; m < 4; ++m) { const int r = ai * HALF + wr * 64 + m * 16 + fr; const float s = tab[u.par * 256 + r];
                    bf16_t* rowp = O2 + (size_t)(u.pm * BM + r) * ldc2 + col0;
#pragma unroll
                    for (int bj = 0; bj < 2; ++bj) *(u32x4*)(rowp + bj * HALF) = pack8(acc[ai][bj][m][0] * s, acc[ai][bj][m][1] * s); }
        }
    }
};
template <int MODE> struct EpiResid {
    static constexpr bool PERM = true, AFTER_DRAIN = false;
    const float* hin; float* hout; bf16_t* hb; float* slots; const bf16_t* E; const LAS float* tab;
    __device__ __forceinline__ void operator()(const f32x4 (&acc)[2][2][4][2], const Unit& u, int wr, int wc, int fr, int fq) const {
        const int col0 = u.aux * BM + wc * 32 + 8 * fq;
#pragma unroll
        for (int ai = 0; ai < 2; ++ai)
#pragma unroll
            for (int m = 0; m < 4; ++m) { const int r = ai * HALF + wr * 64 + m * 16 + fr; const size_t off = (size_t)(u.pm * BM + r) * DM + col0;
                float s = 1.0f; if (MODE == 1) s = tab[u.par * 256 + r];
                float ss = 0.f;
#pragma unroll
                for (int bj = 0; bj < 2; ++bj) {
                    f32x4 v0 = *(const f32x4*)(hin + off + bj * HALF), v1 = *(const f32x4*)(hin + off + bj * HALF + 4);
                    if (MODE == 0) { v0 += acc[ai][bj][m][0]; v1 += acc[ai][bj][m][1]; }
                    else { const u32x4 e = *(const u32x4*)(E + off + bj * HALF); const f32x4 a0 = acc[ai][bj][m][0] * s, a1 = acc[ai][bj][m][1] * s;
                        v0[0] += sigmoidf_(a0[0]) * bf_lo(e.x); v0[1] += sigmoidf_(a0[1]) * bf_hi(e.x); v0[2] += sigmoidf_(a0[2]) * bf_lo(e.y); v0[3] += sigmoidf_(a0[3]) * bf_hi(e.y);
                        v1[0] += sigmoidf_(a1[0]) * bf_lo(e.z); v1[1] += sigmoidf_(a1[1]) * bf_hi(e.z); v1[2] += sigmoidf_(a1[2]) * bf_lo(e.w); v1[3] += sigmoidf_(a1[3]) * bf_hi(e.w); }
                    *(f32x4*)(hout + off + bj * HALF) = v0; *(f32x4*)(hout + off + bj * HALF + 4) = v1;
                    if (hb) *(u32x4*)(hb + off + bj * HALF) = pack8(v0, v1);
                    ss += (v0[0] * v0[0] + v0[1] * v0[1]) + (v0[2] * v0[2] + v0[3] * v0[3]) + (v1[0] * v1[0] + v1[1] * v1[1]) + (v1[2] * v1[2] + v1[3] * v1[3]);
                }
                if (slots) { ss += __shfl_xor(ss, 16); ss += __shfl_xor(ss, 32); if (fq == 0) slots[(size_t)(u.pm * BM + r) * 32 + u.aux * 4 + wc] = ss; }
                asm volatile("" ::: "memory");
            }
    }
};
struct EpiF32S {
    static constexpr bool PERM = true, AFTER_DRAIN = false;
    float* O; int ldc; const LAS float* tab;
    __device__ __forceinline__ void operator()(const f32x4 (&acc)[2][2][4][2], const Unit& u, int wr, int wc, int fr, int fq) const {
        const int col0 = u.aux * BM + wc * 32 + 8 * fq;
#pragma unroll
        for (int ai = 0; ai < 2; ++ai)
#pragma unroll
            for (int m = 0; m < 4; ++m) { const int r = ai * HALF + wr * 64 + m * 16 + fr; const float s = tab[u.par * 256 + r];
                float* rowp = O + (size_t)(u.pm * BM + r) * ldc + col0;
#pragma unroll
                for (int bj = 0; bj < 2; ++bj) { *(f32x4*)(rowp + bj * HALF) = acc[ai][bj][m][0] * s; *(f32x4*)(rowp + bj * HALF + 4) = acc[ai][bj][m][1] * s; } }
    }
};

template <class Epi, class Sched, bool ALIGN_EPI = false, bool SP2 = false>
__device__ __forceinline__ void gemm_phase(LAS unsigned char* lds, const Gemm g, const Sched& S, const Epi& E) {
    const int tid = threadIdx.x, wid = __builtin_amdgcn_readfirstlane(tid >> 6), lane = tid & 63, wr = wid >> 2, wc = wid & 3, fr = lane & 15, fq = lane >> 4;
    int K = g.K; asm volatile("" : "+s"(K));
    const int nt = K / BK;
    unsigned voffA[2], voffB[2];
#pragma unroll
    for (int i = 0; i < 2; ++i) { int R, C; stage_rc(tid * 16 + i * 8192, R, C); const int Rb = Epi::PERM ? ((R & ~31) + perm32(R & 31)) : R;
        voffA[i] = (unsigned)(R * K + C) * 2u; voffB[i] = (unsigned)(Rb * K + C) * 2u; }
    const size_t kstep = (size_t)(BK * 2);
    const size_t hstep = (size_t)HALF * K * 2;
    const size_t tstep = 2 * hstep;
    const unsigned ldsw = (unsigned)wid * 1024u;
    const int aoff = lds_byte(wr * 64 + fr, fq * 8), boff = lds_byte(wc * 32 + fr, fq * 8);
#define PG8_SA(b, h) (((b) * 2 + (h)) * HTB)
#define PG8_SB(b, h) ((4 + (b) * 2 + (h)) * HTB)
#define PG8_STAGE(bufoff, gbase, voff) do { _Pragma("unroll") for (int _i = 0; _i < 2; ++_i) \
        __builtin_amdgcn_global_load_lds((const unsigned*)((const char*)(gbase) + (voff)[_i]), (LAS unsigned*)(lds + (bufoff) + ldsw + _i * 8192), 16, 0, 0); } while (0)
#define PG8_LDA(dst, b, h) do { _Pragma("unroll") for (int m = 0; m < 4; ++m) _Pragma("unroll") for (int k = 0; k < 2; ++k) dst[m][k] = *(const LAS bf16x8*)(lds + PG8_SA(b, h) + aoff + m * 2048 + k * 1024); } while (0)
#define PG8_LDB(dst, b, h) do { _Pragma("unroll") for (int n = 0; n < 2; ++n) _Pragma("unroll") for (int k = 0; k < 2; ++k) dst[n][k] = *(const LAS bf16x8*)(lds + PG8_SB(b, h) + boff + n * 2048 + k * 1024); } while (0)
#define PG8_MMA(ai, bj, At, Bt) do { __builtin_amdgcn_s_setprio(1); _Pragma("unroll") for (int m = 0; m < 4; ++m) _Pragma("unroll") for (int n = 0; n < 2; ++n) _Pragma("unroll") for (int k = 0; k < 2; ++k) \
        acc[ai][bj][m][n] = __builtin_amdgcn_mfma_f32_16x16x32_bf16(Bt[n][k], At[m][k], acc[ai][bj][m][n], 0, 0, 0); __builtin_amdgcn_s_setprio(0); } while (0)
#define PG8_WAIT_V(n) asm volatile("s_waitcnt vmcnt(" #n ")" ::: "memory")
#define PG8_WAIT_L(n) asm volatile("s_waitcnt lgkmcnt(" #n ")" ::: "memory")
#define PG8_BAR __builtin_amdgcn_s_barrier()
#define PG8_SCHED __builtin_amdgcn_sched_barrier(0)
    Unit cur, nxt; int ui = 0;
    if (!S.next(0, cur)) return;
    f32x4 acc[2][2][4][2];
#pragma unroll
    for (int a = 0; a < 2; ++a)
#pragma unroll
        for (int b = 0; b < 2; ++b)
#pragma unroll
            for (int m = 0; m < 4; ++m)
#pragma unroll
                for (int n = 0; n < 2; ++n) acc[a][b][m][n] = (f32x4){0.f, 0.f, 0.f, 0.f};
    bf16x8 At[4][2], B0[2][2], B1[2][2];
    const char* cA = (const char*)g.A + (size_t)cur.pm * tstep; const char* cB = (const char*)g.Bt + (size_t)cur.pn * tstep;
    S.a_ready(cur);
    if constexpr (SP2) {
        PG8_STAGE(PG8_SB(0, 0), cB, voffB); PG8_STAGE(PG8_SB(0, 1), cB + hstep, voffB); PG8_STAGE(PG8_SA(0, 0), cA, voffA); PG8_STAGE(PG8_SA(0, 1), cA + hstep, voffA);
        if (wr == 1) PG8_BAR;
        PG8_WAIT_V(2); PG8_BAR;
        PG8_STAGE(PG8_SB(1, 0), cB + kstep, voffB); PG8_STAGE(PG8_SA(1, 0), cA + kstep, voffA); PG8_STAGE(PG8_SB(1, 1), cB + hstep + kstep, voffB);
        PG8_WAIT_V(6); PG8_BAR;
    } else {
        PG8_STAGE(PG8_SB(0, 0), cB, voffB); PG8_STAGE(PG8_SA(0, 0), cA, voffA); PG8_STAGE(PG8_SB(0, 1), cB + hstep, voffB); PG8_STAGE(PG8_SA(0, 1), cA + hstep, voffA);
        if (wr == 1) PG8_BAR;
        PG8_WAIT_V(4); PG8_BAR;
        PG8_STAGE(PG8_SB(1, 0), cB + kstep, voffB); PG8_STAGE(PG8_SA(1, 0), cA + kstep, voffA); PG8_STAGE(PG8_SB(1, 1), cB + hstep + kstep, voffB);
        PG8_WAIT_V(6); PG8_BAR;
    }
    for (;;) {
        const bool has_next = S.next(ui + 1, nxt);
        const char* nA = has_next ? (const char*)g.A + (size_t)nxt.pm * tstep : cA; const char* nB = has_next ? (const char*)g.Bt + (size_t)nxt.pn * tstep : cB;
        for (int t = 0; t < nt; t += 2) {
            const bool last = (t == nt - 2);
            const char* a1 = cA + (size_t)(t + 1) * kstep;
            const char* a2 = last ? nA : cA + (size_t)(t + 2) * kstep; const char* b2 = last ? nB : cB + (size_t)(t + 2) * kstep;
            const char* a3 = a2 + kstep; const char* b3 = b2 + kstep;
            if (last && has_next) S.a_ready(nxt);
            if constexpr (SP2) {
            PG8_LDB(B0, 0, 0); PG8_LDB(B1, 0, 1); PG8_SCHED; PG8_LDA(At, 0, 0); PG8_STAGE(PG8_SA(1, 1), a1 + hstep, voffA);
            PG8_WAIT_V(8); PG8_WAIT_L(0); PG8_BAR; PG8_MMA(0, 0, At, B0); PG8_MMA(0, 1, At, B1); PG8_BAR; PG8_SCHED;
            PG8_LDA(At, 0, 1); PG8_STAGE(PG8_SB(0, 0), b2, voffB); PG8_STAGE(PG8_SB(0, 1), b2 + hstep, voffB); PG8_STAGE(PG8_SA(0, 0), a2, voffA);
            PG8_WAIT_V(8); PG8_WAIT_L(0); PG8_BAR; PG8_MMA(1, 0, At, B0); PG8_MMA(1, 1, At, B1); PG8_BAR; PG8_SCHED;
            PG8_LDB(B0, 1, 0); PG8_LDB(B1, 1, 1); PG8_SCHED; PG8_LDA(At, 1, 0); PG8_STAGE(PG8_SA(0, 1), a2 + hstep, voffA);
            PG8_WAIT_V(8); PG8_WAIT_L(0); PG8_BAR; PG8_MMA(0, 0, At, B0); PG8_MMA(0, 1, At, B1); PG8_BAR; PG8_SCHED;
            PG8_LDA(At, 1, 1); PG8_STAGE(PG8_SB(1, 0), b3, voffB); PG8_STAGE(PG8_SB(1, 1), b3 + hstep, voffB); PG8_STAGE(PG8_SA(1, 0), a3, voffA);
            PG8_WAIT_V(8); PG8_WAIT_L(0); PG8_BAR; PG8_MMA(1, 0, At, B0); PG8_MMA(1, 1, At, B1); PG8_BAR; PG8_SCHED;
            } else {
            PG8_LDB(B0, 0, 0); PG8_SCHED; PG8_LDA(At, 0, 0); PG8_STAGE(PG8_SA(1, 1), a1 + hstep, voffA);
            PG8_WAIT_L(8); PG8_BAR; PG8_WAIT_L(0); PG8_MMA(0, 0, At, B0); PG8_BAR; PG8_SCHED;
            PG8_LDB(B1, 0, 1); PG8_STAGE(PG8_SB(0, 0), b2, voffB);
            PG8_BAR; PG8_WAIT_L(0); PG8_MMA(0, 1, At, B1); PG8_BAR;
            PG8_LDA(At, 0, 1); PG8_STAGE(PG8_SA(0, 0), a2, voffA);
            PG8_BAR; PG8_WAIT_L(0); PG8_MMA(1, 0, At, B0); PG8_BAR; PG8_SCHED;
            PG8_STAGE(PG8_SB(0, 1), b2 + hstep, voffB);
            PG8_WAIT_V(6); PG8_BAR; PG8_MMA(1, 1, At, B1); PG8_BAR;
            PG8_LDB(B0, 1, 0); PG8_SCHED; PG8_LDA(At, 1, 0); PG8_STAGE(PG8_SA(0, 1), a2 + hstep, voffA);
            PG8_WAIT_L(8); PG8_BAR; PG8_WAIT_L(0); PG8_MMA(0, 0, At, B0); PG8_BAR; PG8_SCHED;
            PG8_LDB(B1, 1, 1); PG8_STAGE(PG8_SB(1, 0), b3, voffB);
            PG8_BAR; PG8_WAIT_L(0); PG8_MMA(0, 1, At, B1); PG8_BAR;
            PG8_LDA(At, 1, 1); PG8_STAGE(PG8_SA(1, 0), a3, voffA);
            PG8_BAR; PG8_WAIT_L(0); PG8_MMA(1, 0, At, B0); PG8_BAR; PG8_SCHED;
            PG8_STAGE(PG8_SB(1, 1), b3 + hstep, voffB);
            PG8_WAIT_V(6); PG8_BAR; PG8_MMA(1, 1, At, B1); PG8_BAR;
            }
        }
        if constexpr (ALIGN_EPI) { if (wr == 0) PG8_BAR; }
        if constexpr (!Epi::AFTER_DRAIN) { E(acc, cur, wr, wc, fr, fq); S.done(cur); }
        if (!has_next) break;
#pragma unroll
        for (int a = 0; a < 2; ++a)
#pragma unroll
            for (int b = 0; b < 2; ++b)
#pragma unroll
                for (int m = 0; m < 4; ++m)
#pragma unroll
                    for (int n = 0; n < 2; ++n) acc[a][b][m][n] = (f32x4){0.f, 0.f, 0.f, 0.f};
        cur = nxt; cA = nA; cB = nB; ++ui;
        if constexpr (ALIGN_EPI) { if (wr == 1) PG8_BAR; }
    }
    PG8_WAIT_V(0);
    if constexpr (!ALIGN_EPI) { if (wr == 0) PG8_BAR; }
    PG8_BAR;
#undef PG8_SA
#undef PG8_SB
#undef PG8_STAGE
#undef PG8_LDA
#undef PG8_LDB
#undef PG8_MMA
#undef PG8_WAIT_V
#undef PG8_WAIT_L
#undef PG8_BAR
#undef PG8_SCHED
}
}

namespace fox {
using bf16 = __hip_bfloat16;
typedef short bf16x8 __attribute__((ext_vector_type(8)));
typedef short s16x4 __attribute__((ext_vector_type(4)));
typedef float f32x16 __attribute__((ext_vector_type(16)));
typedef float f32x4 __attribute__((ext_vector_type(4)));
typedef unsigned u32x4 __attribute__((ext_vector_type(4)));
constexpr int D = 128, LD = DM;
constexpr float SCALE = 0.08838834764831845f;
constexpr float THR = 8.f;
constexpr int NW = 8, QBLK = 32, KVBLK = 64, QB = NW * QBLK;
constexpr int SHM_V = KVBLK * D * 2, SHM_K = KVBLK * D * 2;
constexpr int CB_OFF = 2 * SHM_V + 2 * SHM_K + NW * 64 * 4;
constexpr int QS_OFF = CB_OFF + 2 * SEQ * 4;
constexpr int LDS_BYTES = QS_OFF + NW * 8192;

#define KSWZ(row, colB) ((row) * 256 + ((colB) ^ (((row) & 7) << 4)))
#define SBAR() __builtin_amdgcn_sched_barrier(0)
__device__ __forceinline__ int v_st(int k, int c) { const int kk = (k & ~0xC) | ((k & 4) << 1) | ((k & 8) >> 1); return ((kk >> 3) * 4 + (c >> 5)) * 512 + ((kk & 7) * 32 + (c & 31)) * 2; }
__device__ __forceinline__ int v_rd_base(int lane) { return ((lane & 3) << 3) | (((lane >> 2) & 3) << 6) | (((lane >> 4) & 1) << 5) | (((lane >> 5) & 1) << 8); }
constexpr int v_rd_off(int d0, int ks, int half) { return d0 * 512 + ks * 4096 + half * 2048; }
__device__ __forceinline__ int crow(int r, int hi) { return (r & 3) + 8 * (r >> 2) + 4 * hi; }
__device__ __forceinline__ unsigned cvtpk(float lo, float hi) { unsigned r; asm volatile("v_cvt_pk_bf16_f32 %0, %1, %2" : "=v"(r) : "v"(lo), "v"(hi)); return r; }
__device__ __forceinline__ bf16x8 load8(const bf16* p) { return *reinterpret_cast<const bf16x8*>(p); }
__device__ __forceinline__ void mask_tile(f32x16& p0, f32x16& p1, int dq) {
    const float NEG = -__builtin_inff();
#pragma unroll
    for (int r = 0; r < 16; ++r) {
        const int c = (r & 3) + 8 * (r >> 2);
        if (dq - c < 0) p0[r] = NEG;
        if (dq - c - 32 < 0) p1[r] = NEG;
    }
}
__device__ __forceinline__ void partialSM(f32x16& p0, f32x16& p1, float& m_reg, float& mn, float& alpha) {
    float pmax = p0[0]; for (int r = 1; r < 16; ++r) pmax = fmaxf(pmax, p0[r]); for (int r = 0; r < 16; ++r) pmax = fmaxf(pmax, p1[r]);
    { auto rr = __builtin_amdgcn_permlane32_swap(__float_as_uint(pmax), __float_as_uint(pmax), false, false);
      pmax = fmaxf(__uint_as_float(rr[0]), __uint_as_float(rr[1])); }
    constexpr float C2 = 1.4426950408889634f * SCALE;
    if (__builtin_expect(__all((pmax - m_reg) * SCALE <= THR), 1)) { mn = m_reg; alpha = 1.f; }
    else { mn = fmaxf(m_reg, pmax); alpha = __builtin_amdgcn_exp2f((m_reg - mn) * C2); m_reg = mn; }
    const float mnL = -mn * C2;
    for (int r = 0; r < 16; ++r) p0[r] = fmaf(p0[r], C2, mnL); for (int r = 0; r < 16; ++r) p1[r] = fmaf(p1[r], C2, mnL);
    for (int r = 0; r < 16; ++r) p0[r] = __builtin_amdgcn_exp2f(p0[r]);
}
__device__ __forceinline__ void finishSM(f32x16& p0, f32x16& p1, float alpha, float& l_reg, bf16x8& pa0, bf16x8& pa1, bf16x8& pa2, bf16x8& pa3) {
    for (int r = 0; r < 16; ++r) p1[r] = __builtin_amdgcn_exp2f(p1[r]);
    float ps = 0; for (int r = 0; r < 16; ++r) ps += p0[r]; for (int r = 0; r < 16; ++r) ps += p1[r];
    { auto rr = __builtin_amdgcn_permlane32_swap(__float_as_uint(ps), __float_as_uint(ps), false, false);
      ps = __uint_as_float(rr[0]) + __uint_as_float(rr[1]); }
    l_reg = l_reg * alpha + ps;
#define PK4(P, B_, OUT) do { unsigned a0 = cvtpk(P[B_+0], P[B_+1]), a1 = cvtpk(P[B_+2], P[B_+3]);                          \
        unsigned b0 = cvtpk(P[B_+4], P[B_+5]), b1 = cvtpk(P[B_+6], P[B_+7]);                                             \
        auto r0 = __builtin_amdgcn_permlane32_swap(a0, b0, false, false); auto r1 = __builtin_amdgcn_permlane32_swap(a1, b1, false, false); \
        u32x4 w = {r0[0], r1[0], r0[1], r1[1]}; OUT = *reinterpret_cast<bf16x8*>(&w); } while (0)
    PK4(p0, 0, pa0); PK4(p0, 8, pa1); PK4(p1, 0, pa2); PK4(p1, 8, pa3);
#undef PK4
}
template <int KB>
__device__ __forceinline__ void qkt(f32x16& p0, f32x16& p1, const char* K_lds, int r32, int hi, const char* qs, const float* cbt) {
    { const f32x4 a0 = *(const f32x4*)(cbt), a1 = *(const f32x4*)(cbt + 8), a2 = *(const f32x4*)(cbt + 16), a3 = *(const f32x4*)(cbt + 24);
      const f32x4 b0 = *(const f32x4*)(cbt + 32), b1 = *(const f32x4*)(cbt + 40), b2 = *(const f32x4*)(cbt + 48), b3 = *(const f32x4*)(cbt + 56);
      p0 = (f32x16){a0[0], a0[1], a0[2], a0[3], a1[0], a1[1], a1[2], a1[3], a2[0], a2[1], a2[2], a2[3], a3[0], a3[1], a3[2], a3[3]};
      p1 = (f32x16){b0[0], b0[1], b0[2], b0[3], b1[0], b1[1], b1[2], b1[3], b2[0], b2[1], b2[2], b2[3], b3[0], b3[1], b3[2], b3[3]}; }
    const char* kb[4];
#pragma unroll
    for (int dd = 0; dd < 4; ++dd) kb[dd] = K_lds + KB * SHM_K + KSWZ(r32, (dd * 16 + hi * 8) * 2);
#pragma unroll
    for (int d0 = 0; d0 < 8; ++d0) { const char* a = kb[d0 & 3] + (d0 >> 2) * 128;
        bf16x8 b0 = *reinterpret_cast<const bf16x8*>(a);
        bf16x8 b1 = *reinterpret_cast<const bf16x8*>(a + 32 * 256);
        const bf16x8 q = *reinterpret_cast<const bf16x8*>(qs + d0 * 1024);
        p0 = __builtin_amdgcn_mfma_f32_32x32x16_bf16(b0, q, p0, 0, 0, 0);
        p1 = __builtin_amdgcn_mfma_f32_32x32x16_bf16(b1, q, p1, 0, 0, 0); }
}
template <int VB>
__device__ __forceinline__ void pv_tile(f32x16* o, int vb0, bf16x8 pa0, bf16x8 pa1, bf16x8 pa2, bf16x8 pa3) {
#define TRRD(dst, off) asm volatile("ds_read_b64_tr_b16 %0, %1 offset:%2" : "=&v"(dst) : "v"(vb0), "i"(off) : "memory")
#define PV_D0(d0) do { s16x4 l0, l1, l2, l3, h0, h1, h2, h3; constexpr int b_ = VB * SHM_V + v_rd_off(d0, 0, 0); \
        TRRD(l0, b_); TRRD(h0, b_ + 2048); TRRD(l1, b_ + 4096); TRRD(h1, b_ + 6144); TRRD(l2, b_ + 8192); TRRD(h2, b_ + 10240); TRRD(l3, b_ + 12288); TRRD(h3, b_ + 14336); \
        asm volatile("s_waitcnt lgkmcnt(0)" ::: "memory"); SBAR();   \
        o[d0] = __builtin_amdgcn_mfma_f32_32x32x16_bf16(pa0, (bf16x8){l0[0], l0[1], l0[2], l0[3], h0[0], h0[1], h0[2], h0[3]}, o[d0], 0, 0, 0);   \
        o[d0] = __builtin_amdgcn_mfma_f32_32x32x16_bf16(pa1, (bf16x8){l1[0], l1[1], l1[2], l1[3], h1[0], h1[1], h1[2], h1[3]}, o[d0], 0, 0, 0);   \
        o[d0] = __builtin_amdgcn_mfma_f32_32x32x16_bf16(pa2, (bf16x8){l2[0], l2[1], l2[2], l2[3], h2[0], h2[1], h2[2], h2[3]}, o[d0], 0, 0, 0);   \
        o[d0] = __builtin_amdgcn_mfma_f32_32x32x16_bf16(pa3, (bf16x8){l3[0], l3[1], l3[2], l3[3], h3[0], h3[1], h3[2], h3[3]}, o[d0], 0, 0, 0); } while (0)
    PV_D0(0); PV_D0(1); PV_D0(2); PV_D0(3);
#undef PV_D0
#undef TRRD
}
struct Ptrs { const bf16* Q; const bf16* K; const bf16* V; bf16* O; const float* CB; };
struct BlockRef { unsigned qoff, kvoff, cboff; int P0; };
struct Seam { bf16x8 qr[8]; bf16x8 st_v0, st_v1, st_k0, st_k1; };
#define ROW(p, k0, rr) ((p) + (size_t)((k0) + (rr)) * LD + sc)
#define VMW() asm volatile("s_waitcnt vmcnt(0)" ::: "memory")
#define VMWN(n) asm volatile("s_waitcnt vmcnt(%0)" :: "i"(n) : "memory")
#define SLOAD_H(Kp, Vp, k0) do { S.st_v0 = load8(ROW(Vp, k0, sr)); S.st_v1 = load8(ROW(Vp, k0, 32 + sr));              \
                         S.st_k0 = load8(ROW(Kp, k0, sr)); S.st_k1 = load8(ROW(Kp, k0, 32 + sr)); } while (0)
#define SWRITE_HK(bf) do { *(bf16x8*)(K_lds + (bf) * SHM_K + kws) = S.st_k0; *(bf16x8*)(K_lds + (bf) * SHM_K + kws + 32 * 256) = S.st_k1; } while (0)
#define SWRITE_HV(bf) do { *(bf16x8*)(V_lds + (bf) * SHM_V + vst0) = S.st_v0; *(bf16x8*)(V_lds + (bf) * SHM_V + vst1) = S.st_v1; } while (0)
#define SWRITE_H(bf) do { SWRITE_HV(bf); SWRITE_HK(bf); } while (0)
__device__ __forceinline__ void load_cb(const Ptrs& P, const BlockRef& b, char* lds, int par) {
    const int tid = threadIdx.x; float* dst = (float*)(lds + CB_OFF + par * (SEQ * 4));
    if (4 * tid < b.P0 + QB) *(f32x4*)(dst + 4 * tid) = *(const f32x4*)(P.CB + b.cboff + 4 * tid);
}
__device__ __forceinline__ void fox_prime(const Ptrs& P, const BlockRef& cur, char* lds, Seam& S) {
    const int tid = threadIdx.x, wid = __builtin_amdgcn_readfirstlane(tid >> 6), lane = tid & 63, r32 = lane & 31, hi = lane >> 5;
    const int sr = tid >> 4, sc = (tid & 15) * 8, kws = KSWZ(sr, sc * 2); char* K_lds = lds + 2 * SHM_V;
    for (int d0 = 0; d0 < 8; ++d0) S.qr[d0] = load8(P.Q + cur.qoff + (size_t)(wid * QBLK + r32) * LD + d0 * 16 + hi * 8);
    SLOAD_H(P.K + cur.kvoff, P.V + cur.kvoff, 0); VMW(); SWRITE_HK(0);
    load_cb(P, cur, lds, 0);
    __syncthreads();
}
__device__ __forceinline__ void fox_block(const Ptrs& P, const BlockRef& cur, const BlockRef& nxt, int par, char* lds, Seam& S) {
    const int tid = threadIdx.x, wid = __builtin_amdgcn_readfirstlane(tid >> 6), lane = tid & 63, r32 = lane & 31, hi = lane >> 5;
    const int NT = (cur.P0 + QB) / KVBLK;
    const int qlo = cur.P0 + wid * QBLK, qm = qlo + r32 - 4 * hi;
    char* V_lds = lds; char* K_lds = lds + 2 * SHM_V;
    float* ws = (float*)(lds + 2 * SHM_V + 2 * SHM_K) + wid * 64; float* li_l = ws, * al_l = ws + 32;
    const float* cbl = (const float*)(lds + CB_OFF + par * (SEQ * 4)) + 4 * hi;
    float m_reg = -1e30f, l_reg = 0; f32x16 o[4] = {};
    const int sr = tid >> 4, sc = (tid & 15) * 8, vst0 = v_st(sr, sc), vst1 = v_st(32 + sr, sc), kws = KSWZ(sr, sc * 2);
    const int vb0 = (int)(uintptr_t)V_lds + v_rd_base(lane);
    const bf16* Kh = P.K + cur.kvoff; const bf16* Vh = P.V + cur.kvoff;
    char* qs = lds + QS_OFF + wid * 8192 + lane * 16;
#define RESC(a) do { if (__any((a) < 1.f)) { if (hi == 0) al_l[r32] = (a); asm volatile("s_waitcnt lgkmcnt(0)" ::: "memory");              \
                     for (int d_ = 0; d_ < 4; ++d_) for (int r = 0; r < 16; ++r) o[d_][r] *= al_l[crow(r, hi)]; } } while (0)
#define KBASE(t) ((t) * KVBLK)
#define MASKT(P0_, P1_, t) do { const int kb_ = KBASE(t); if (kb_ + KVBLK - 1 > qlo) mask_tile(P0_, P1_, qm - kb_); } while (0)
    constexpr int NQL = 8;
#define SEAM_K0() do { VMWN(NQL); SWRITE_HK(0); SBAR(); } while (0)
    f32x16 pA0, pA1, pB0, pB1; float mnA, mnB, alA, alB; bf16x8 pa0, pa1, pa2, pa3;
    SWRITE_HV(0);
#pragma unroll
    for (int d0 = 0; d0 < 8; ++d0) *(bf16x8*)(qs + d0 * 1024) = S.qr[d0];
    SBAR();
    if (NT > 1) { SLOAD_H(Kh, Vh, KBASE(1)); }
    SBAR(); qkt<0>(pA0, pA1, K_lds, r32, hi, qs, cbl);
    MASKT(pA0, pA1, 0); partialSM(pA0, pA1, m_reg, mnA, alA);
    if (NT > 1) { VMW(); SWRITE_H(1); }
    __syncthreads();
#define HALF_STEP(PX0, PX1, mnX, alX, PY0, PY1, alY, t, KB, VB, SB) do {                                                      \
        SBAR(); qkt<KB>(PX0, PX1, K_lds, r32, hi, qs, cbl + (t) * KVBLK);                                                   \
        finishSM(PY0, PY1, alY, l_reg, pa0, pa1, pa2, pa3); SBAR();                                                           \
        if ((t) + 1 < NT) { SLOAD_H(Kh, Vh, KBASE((t) + 1)); SBAR(); }                                                        \
        pv_tile<VB>(o, vb0, pa0, pa1, pa2, pa3); MASKT(PX0, PX1, (t)); partialSM(PX0, PX1, m_reg, mnX, alX);                  \
        __syncthreads();                                                                                                      \
        if ((t) + 1 < NT) { VMW(); SWRITE_H(SB); }                                                                            \
        RESC(alX); __syncthreads(); } while (0)
    for (int t = 1; t + 1 < NT; t += 2) {
        HALF_STEP(pB0, pB1, mnB, alB, pA0, pA1, alA, t, 1, 0, 0);
        HALF_STEP(pA0, pA1, mnA, alA, pB0, pB1, alB, t + 1, 0, 1, 1);
    }
    const bool even = (NT & 1) == 0;
    if (even) { SBAR(); qkt<1>(pB0, pB1, K_lds, r32, hi, qs, cbl + (NT - 1) * KVBLK); SBAR(); }
    SLOAD_H(P.K + nxt.kvoff, P.V + nxt.kvoff, 0); SBAR();
#pragma unroll
    for (int d0 = 0; d0 < 8; ++d0) S.qr[d0] = load8(P.Q + nxt.qoff + (size_t)(wid * QBLK + r32) * LD + d0 * 16 + hi * 8);
    SBAR();
    finishSM(pA0, pA1, alA, l_reg, pa0, pa1, pa2, pa3); SBAR();
    pv_tile<0>(o, vb0, pa0, pa1, pa2, pa3);
    if (even) { MASKT(pB0, pB1, NT - 1); partialSM(pB0, pB1, m_reg, mnB, alB); __syncthreads(); RESC(alB);
        finishSM(pB0, pB1, alB, l_reg, pa0, pa1, pa2, pa3); SBAR(); pv_tile<1>(o, vb0, pa0, pa1, pa2, pa3); }
    SBAR(); SEAM_K0();
    if (hi == 0) li_l[r32] = l_reg; asm volatile("s_waitcnt lgkmcnt(0)" ::: "memory");
    float rli[16];
#pragma unroll
    for (int r = 0; r < 16; ++r) rli[r] = __builtin_amdgcn_rcpf(li_l[crow(r, hi)]);
    bf16* Ow = P.O + cur.qoff + (size_t)(wid * QBLK) * LD;
#pragma unroll
    for (int r = 0; r < 16; ++r) { const int orow = crow(r, hi);
#pragma unroll
        for (int d0 = 0; d0 < 4; ++d0) { const float v = o[d0][r] * rli[r];
            const float vn = __shfl_xor(v, 1);
            if ((r32 & 1) == 0) *(unsigned*)(Ow + (size_t)orow * LD + d0 * 32 + r32) = cvtpk(v, vn); } }
    load_cb(P, nxt, lds, par ^ 1);
    __syncthreads();
#undef RESC
#undef KBASE
#undef MASKT
#undef SEAM_K0
#undef HALF_STEP
}
__device__ __forceinline__ BlockRef mk_ref(int L_, int pass) {
    const int bh = L_ >> 2, x = L_ & 3, qb = pass ? 7 - x : x, b = bh / NH, hh = bh - b * NH;
    BlockRef r; r.qoff = (unsigned)((b * SEQ + qb * QB) * DM + hh * HD); r.kvoff = (unsigned)(b * SEQ * DM + hh * HD); r.cboff = (unsigned)(bh * SEQ); r.P0 = qb * QB; return r; }
#undef ROW
#undef VMW
#undef VMWN
#undef SLOAD_H
#undef SWRITE_HK
#undef SWRITE_HV
#undef SWRITE_H
#undef KSWZ
#undef SBAR
}

constexpr int NWAVES = 8;
typedef unsigned short bf16;
typedef unsigned v4u __attribute__((ext_vector_type(4)));
typedef float f32x4 __attribute__((ext_vector_type(4)));
typedef GAS unsigned gu32;
#define RLX_AGENT __ATOMIC_RELAXED, __HIP_MEMORY_SCOPE_AGENT
#define LDS_WAIT() asm volatile("s_waitcnt lgkmcnt(0)" ::: "memory")
#define VM_WAIT() asm volatile("s_waitcnt vmcnt(0)" ::: "memory")
__device__ __forceinline__ unsigned f2bf(float f) { unsigned u = __builtin_bit_cast(unsigned, f); return (u + 0x7fffu + ((u >> 16) & 1u)) >> 16; }
__device__ __forceinline__ unsigned pk2(float lo, float hi) { return f2bf(lo) | (f2bf(hi) << 16); }

constexpr size_t MiB = 1u << 20;
constexpr size_t al1(size_t x) { return (x + MiB - 1) / MiB * MiB; }
constexpr size_t WS_CTL = 0, CTL_ZERO_BYTES = 64 * 1024;
constexpr size_t SZ_TD = (size_t)T * DM * 2;
constexpr size_t WS_WCI = 1 * MiB;
constexpr size_t WS_WCO = WS_WCI + al1((size_t)3 * DM * DM * 2);
constexpr size_t WS_WGU = WS_WCO + al1((size_t)DM * DM * 2);
constexpr size_t WS_WFD = WS_WGU + al1((size_t)2 * DFF * DM * 2);
constexpr size_t WS_WPG = WS_WFD + al1((size_t)DM * DFF * 2);
constexpr size_t WS_WPU = WS_WPG + al1((size_t)2 * DM * DM * 2);
constexpr size_t WS_WQKV = WS_WPU + al1((size_t)2 * DM * PLE * 2);
constexpr size_t WS_WO = WS_WQKV + al1((size_t)3 * DM * DM * 2);
constexpr size_t WS_WMGU = WS_WO + al1((size_t)DM * DM * 2);
constexpr size_t WS_WMD = WS_WMGU + al1((size_t)NE * 2 * DFE * DM * 2);
constexpr size_t WS_WF = WS_WMD + al1((size_t)NE * DM * DFE * 2);
constexpr size_t WS_WR = WS_WF + al1((size_t)NH * DM * 4);
constexpr size_t WS_HB = WS_WR + al1((size_t)DM * NE * 4);
constexpr size_t WS_HB2 = WS_HB + al1(SZ_TD);
constexpr size_t WS_PB = WS_HB2 + al1(SZ_TD);
constexpr size_t WS_E0 = WS_PB + al1((size_t)2 * T * PLE * 2);
constexpr size_t WS_E1 = WS_E0 + SZ_TD;
constexpr size_t WS_U = WS_E1 + al1(SZ_TD);
constexpr size_t WS_BG = WS_U + al1(SZ_TD);
constexpr size_t WS_YB = WS_BG + al1(SZ_TD);
constexpr size_t WS_ACT = WS_YB + al1(SZ_TD);
constexpr size_t WS_Q = WS_ACT + al1((size_t)T * DFF * 2);
constexpr size_t WS_K = WS_Q + al1(SZ_TD);
constexpr size_t WS_V = WS_K + al1(SZ_TD);
constexpr size_t WS_O = WS_V + al1(SZ_TD);
constexpr size_t WS_LF = WS_O + al1(SZ_TD);
constexpr size_t WS_CB = WS_LF + al1((size_t)T * NH * 4);
constexpr size_t WS_SL1 = WS_CB + al1((size_t)T * NH * 4);
constexpr size_t WS_SL2 = WS_SL1 + al1((size_t)T * 32 * 4);
constexpr size_t WS_SL3 = WS_SL2 + al1((size_t)T * 32 * 4);
constexpr size_t WS_RSTD = WS_SL3 + al1((size_t)T * 32 * 4);
constexpr size_t WS_ROUTE = WS_RSTD + al1((size_t)3 * T * 4);
constexpr size_t WS_XG = WS_ROUTE + 1 * MiB;
constexpr size_t WS_RG = WS_XG + al1((size_t)MAXROWS * DM * 2);
constexpr size_t WS_ACTM = WS_RG + 1 * MiB;
constexpr size_t WS_YM = WS_ACTM + al1((size_t)MAXROWS * DFE * 2);
constexpr size_t WS_END = WS_YM + al1((size_t)MAXROWS * DM * 4);
constexpr int CW_BAR = 1024;

constexpr int RING_OFF = 0, RING_BYTES = 131072;
constexpr int TAB_OFF = RING_BYTES;
constexpr int LDS_BYTES = 163840;
constexpr int MISC_OFF = LDS_BYTES - 512;
static_assert(TAB_OFF + 2048 <= MISC_OFF, "LDS map");
static_assert(fox::LDS_BYTES <= MISC_OFF, "attention LDS (overlays the row-scale tables, which are idle in that phase)");

#define XB_TMO      128
#define XB_XCNT(j)  (256  + 64 * (j))
#define XB_XSUB(j)  (1280 + 64 * (j))
#define XB_XGEN(j)  (2304 + 64 * (j))
#define XB_TOP      3328
#define XB_TOPGEN   3392
#define XCD_BAR_WORDS 3456
#define XB_SPIN_CAP (1u << 22)
__device__ __forceinline__ unsigned xb_ld(unsigned* p)              { return __hip_atomic_load(p, __ATOMIC_RELAXED, __HIP_MEMORY_SCOPE_AGENT); }
__device__ __forceinline__ unsigned xb_add(unsigned* p, unsigned v) { return __hip_atomic_fetch_add(p, v, __ATOMIC_RELAXED, __HIP_MEMORY_SCOPE_AGENT); }
__device__ __forceinline__ unsigned xb_xcc_id() { return (unsigned)__builtin_amdgcn_s_getreg((3 << 11) | 20) & 0xFu; }
#define XB_SPIN(cond, bar) do { unsigned _sp = 0; while (cond) { __builtin_amdgcn_s_sleep(1); \
    if ((++_sp & 255u) == 0u) { if (xb_ld(&(bar)[XB_TMO])) break; if (_sp > XB_SPIN_CAP) { atomicAdd(&(bar)[XB_TMO], 1u); break; } } } } while (0)
struct XcdBarrier { unsigned* bar; unsigned x; volatile LAS unsigned* st; };
__device__ __forceinline__ XcdBarrier xcd_barrier_post(unsigned* bar, volatile LAS unsigned* st) {
    XcdBarrier b; b.bar = bar; b.x = xb_xcc_id(); b.st = st;
    if (threadIdx.x == 0) (void)xb_add(&bar[XB_XCNT(b.x)], 1u);
    return b;
}
__device__ __forceinline__ void xcd_barrier_complete(unsigned* bar, unsigned x, unsigned& nloc, unsigned& nx) {
    const unsigned G = gridDim.x * gridDim.y * gridDim.z;
    unsigned sum, cnt, mine, sp = 0u;
    for (;;) {
        sum = 0u; cnt = 0u; mine = 0u;
#pragma unroll
        for (unsigned j = 0; j < 16; ++j) { const unsigned c = xb_ld(&bar[XB_XCNT(j)]); sum += c; cnt += (c > 0u) ? 1u : 0u; mine = (j == x) ? c : mine; }
        if (sum == G) break;
        __builtin_amdgcn_s_sleep(1);
        if ((++sp & 255u) == 0u) { if (xb_ld(&bar[XB_TMO])) break; if (sp > XB_SPIN_CAP) { atomicAdd(&bar[XB_TMO], 1u); break; } }
    }
    nloc = mine > 0u ? mine : 1u; nx = cnt > 0u ? cnt : 1u;
}
__device__ __forceinline__ void xcd_barrier(const XcdBarrier& b) {
    asm volatile("s_waitcnt vmcnt(0)" ::: "memory");
    __syncthreads();
    if (threadIdx.x == 0) {
        unsigned* bar = b.bar;
        __builtin_amdgcn_s_waitcnt(0);
        unsigned nloc = b.st[0], nx = b.st[1];
        if (nloc == 0u) { xcd_barrier_complete(bar, b.x, nloc, nx); b.st[0] = nloc; b.st[1] = nx; }
        const unsigned old = xb_add(&bar[XB_XSUB(b.x)], 1u);
        const unsigned gen = old / nloc;
        if (old + 1u == (gen + 1u) * nloc) {
            __builtin_amdgcn_fence(__ATOMIC_RELEASE, "agent");
            asm volatile("s_waitcnt vmcnt(0)" ::: "memory");
            const unsigned og = xb_add(&bar[XB_TOP], 1u);
            const unsigned tg = og / nx;
            if (og + 1u == (tg + 1u) * nx) xb_add(&bar[XB_TOPGEN], 1u);
            else XB_SPIN(xb_ld(&bar[XB_TOPGEN]) == tg, bar);
            __builtin_amdgcn_fence(__ATOMIC_ACQUIRE, "agent");
            xb_add(&bar[XB_XGEN(b.x)], 1u);
            asm volatile("s_waitcnt vmcnt(0)" ::: "memory");
        } else {
            XB_SPIN(xb_ld(&bar[XB_XGEN(b.x)]) == gen, bar);
            __builtin_amdgcn_fence(__ATOMIC_ACQUIRE, "agent");
            asm volatile("s_waitcnt vmcnt(0)" ::: "memory");
        }
    }
    __syncthreads();
}

struct Frame {
    LAS unsigned char* lds;
    volatile LAS unsigned* MISC;
    LAS float* tab;
    gu32* ctl;
    int tid, lane, wave;
    int vcu, G;
    float* out; unsigned char* ws;
};
__device__ __forceinline__ const float* arg_in(int i) {
    const __attribute__((address_space(4))) char* ka = (const __attribute__((address_space(4))) char*)__builtin_amdgcn_kernarg_segment_ptr();
    asm volatile("" : "+s"(ka));
    return *(const float* const __attribute__((address_space(4)))*)(ka + 8 * i);
}

__device__ __forceinline__ float wave_sum(float v) {
#pragma unroll
    for (int o = 1; o < 64; o <<= 1) v += __shfl_xor(v, o);
    return v;
}

struct CvtJob { const float* W; int ld; int Kg; int groups; int N; const float* gain; int map; int F; bf16* dst; };
__device__ __forceinline__ int cvt_items(const CvtJob& j) { return j.groups * (j.Kg / 64) * (j.N / 32); }
__device__ __forceinline__ int map_col(int map, int F, int n0) {
    if (map == 1) { if (n0 < DM) return 2 * DM + n0; const int c = (n0 - DM) & (DM - 1), isx = (n0 >= 2 * DM); return 256 * (c >> 7) + (isx ? 128 : 0) + (c & 127); }
    if (map == 2) { const int isu = n0 >= F, c = isu ? n0 - F : n0; return 256 * (c >> 7) + (isu ? 128 : 0) + (c & 127); }
    return n0;
}
__device__ __forceinline__ void cvt_item(const CvtJob& j, LAS float* scr, int item, int lane) {
    const int nblk = j.N / 32, kpg = j.Kg / 64; const int kb = item / nblk, nb = item - kb * nblk, grp = kb / kpg, kl = kb - grp * kpg, k0 = 64 * kl, n0 = 32 * nb;
    const float* Wg = j.W + (size_t)grp * j.Kg * j.ld; const float* gn = j.gain ? j.gain + (size_t)grp * j.Kg : nullptr;
#pragma unroll 8
    for (int i = 0; i < 32; ++i) { const int kk = 2 * i + (lane >> 5); float v = Wg[(size_t)(k0 + kk) * j.ld + n0 + (lane & 31)]; if (gn) v *= gn[k0 + kk]; scr[kk * 33 + (lane & 31)] = v; }
    LDS_WAIT(); asm volatile("" ::: "memory");
    const int c = lane & 7; const int d0 = map_col(j.map, j.F, n0);
    bf16* D = j.dst + (size_t)grp * j.N * j.Kg;
#pragma unroll
    for (int q = 0; q < 4; ++q) { const int n = (lane >> 3) + 8 * q; const LAS float* s = scr + (8 * c) * 33 + n;
        v4u o; o.x = pk2(s[0 * 33], s[1 * 33]); o.y = pk2(s[2 * 33], s[3 * 33]); o.z = pk2(s[4 * 33], s[5 * 33]); o.w = pk2(s[6 * 33], s[7 * 33]);
        *(GAS v4u*)(D + (size_t)(d0 + n) * j.Kg + k0 + 8 * c) = o; }
    LDS_WAIT(); asm volatile("" ::: "memory");
}
__device__ __forceinline__ void p0_prologue(Frame& F) {
    LAS float* scr = (LAS float*)(F.lds + RING_OFF + F.wave * 16384);
    const int gw = F.vcu * NWAVES + F.wave, NGW = F.G * NWAVES;
    unsigned char* ws = F.ws;
    constexpr int I0 = (DM / 64) * (3 * DM / 32), I1 = (DM / 64) * (DM / 32), I2 = (DM / 64) * (2 * DFF / 32), I3 = (DFF / 64) * (DM / 32), I4 = 2 * (DM / 64) * (DM / 32), I5 = 2 * (PLE / 64) * (DM / 32),
                  I6 = I1, I7 = (DM / 64) * (2 * DM / 32), I8 = I1, I9P = (DM / 64) * (2 * DFE / 32), I9 = NE * I9P, I10 = NE * (DFE / 64) * (DM / 32);
    constexpr int NITEMS = I0 + I1 + I2 + I3 + I4 + I5 + I6 + I7 + I8 + I9 + I10;
    for (int it = gw; it < NITEMS; it += NGW) {
        int r = it;
        if (r < I0) { const CvtJob j{arg_in(5), 3 * DM, DM, 1, 3 * DM, arg_in(2), 1, 0, (bf16*)(ws + WS_WCI)}; cvt_item(j, scr, r, F.lane); continue; } r -= I0;
        if (r < I1) { const CvtJob j{arg_in(7), DM, DM, 1, DM, nullptr, 0, 0, (bf16*)(ws + WS_WCO)}; cvt_item(j, scr, r, F.lane); continue; } r -= I1;
        if (r < I2) { const CvtJob j{arg_in(15), 2 * DFF, DM, 1, 2 * DFF, arg_in(3), 2, DFF, (bf16*)(ws + WS_WGU)}; cvt_item(j, scr, r, F.lane); continue; } r -= I2;
        if (r < I3) { const CvtJob j{arg_in(16), DM, DFF, 1, DM, nullptr, 0, 0, (bf16*)(ws + WS_WFD)}; cvt_item(j, scr, r, F.lane); continue; } r -= I3;
        if (r < I4) { const CvtJob j{arg_in(21), DM, DM, 2, DM, arg_in(4), 0, 0, (bf16*)(ws + WS_WPG)}; cvt_item(j, scr, r, F.lane); continue; } r -= I4;
        if (r < I5) { const CvtJob j{arg_in(20), DM, PLE, 2, DM, nullptr, 0, 0, (bf16*)(ws + WS_WPU)}; cvt_item(j, scr, r, F.lane); continue; } r -= I5;
        if (r < I6) { const CvtJob j{arg_in(12), DM, DM, 1, DM, arg_in(2) + DM, 0, 0, (bf16*)(ws + WS_WQKV)}; cvt_item(j, scr, r, F.lane); continue; } r -= I6;
        if (r < I7) { const CvtJob j{arg_in(9), 2 * DM + NH, DM, 1, 2 * DM, arg_in(8), 0, 0, (bf16*)(ws + WS_WQKV) + (size_t)DM * DM}; cvt_item(j, scr, r, F.lane); continue; } r -= I7;
        if (r < I8) { const CvtJob j{arg_in(14), DM, DM, 1, DM, nullptr, 0, 0, (bf16*)(ws + WS_WO)}; cvt_item(j, scr, r, F.lane); continue; } r -= I8;
        if (r < I9) { const int grp = r / I9P;
            const CvtJob j{arg_in(18) + (size_t)grp * DM * 2 * DFE, 2 * DFE, DM, 1, 2 * DFE, arg_in(3) + DM, 2, DFE, (bf16*)(ws + WS_WMGU) + (size_t)grp * 2 * DFE * DM}; cvt_item(j, scr, r - grp * I9P, F.lane); continue; } r -= I9;
        { const CvtJob j{arg_in(19), DM, DFE, NE, DM, nullptr, 0, 0, (bf16*)(ws + WS_WMD)}; cvt_item(j, scr, r, F.lane); }
    }
    {
        const int gt = gw * 64 + F.lane, NGT = NGW * 64;
        float* Wf = (float*)(ws + WS_WF); float* Wr = (float*)(ws + WS_WR);
        for (int i = gt; i < NH * DM; i += NGT) { const int h = i / DM, k = i - h * DM; Wf[i] = arg_in(8)[k] * arg_in(9)[(size_t)k * (2 * DM + NH) + 2 * DM + h]; }
        for (int i = gt; i < DM * NE; i += NGT) { const int k = i / NE; Wr[i] = arg_in(3)[DM + k] * arg_in(17)[i]; }
        const f32x4* p4 = (const f32x4*)arg_in(1); unsigned long long* pb = (unsigned long long*)(ws + WS_PB);
        for (int i = gt; i < 2 * T * PLE / 4; i += NGT) { const f32x4 v = p4[i]; pb[i] = (unsigned long long)pk2(v[0], v[1]) | ((unsigned long long)pk2(v[2], v[3]) << 32); }
    }
    {
        const float* x = arg_in(0); bf16* hb = (bf16*)(ws + WS_HB); float* rstd0 = (float*)(ws + WS_RSTD);
        for (int m = gw; m < T; m += NGW) {
            const f32x4* xr = (const f32x4*)(x + (size_t)m * DM) + 2 * F.lane; f32x4 v[4][2]; float s = 0.f;
#pragma unroll
            for (int j = 0; j < 4; ++j) { v[j][0] = xr[128 * j]; v[j][1] = xr[128 * j + 1];
                s += (v[j][0][0] * v[j][0][0] + v[j][0][1] * v[j][0][1]) + (v[j][0][2] * v[j][0][2] + v[j][0][3] * v[j][0][3]) + (v[j][1][0] * v[j][1][0] + v[j][1][1] * v[j][1][1]) + (v[j][1][2] * v[j][1][2] + v[j][1][3] * v[j][1][3]); }
            s = wave_sum(s);
            if (F.lane == 0) rstd0[m] = 1.0f / sqrtf(s * (1.0f / DM) + RMS_EPS);
            v4u* o = (v4u*)(hb + (size_t)m * DM) + F.lane;
#pragma unroll
            for (int j = 0; j < 4; ++j) { v4u w; w.x = pk2(v[j][0][0], v[j][0][1]); w.y = pk2(v[j][0][2], v[j][0][3]); w.z = pk2(v[j][1][0], v[j][1][1]); w.w = pk2(v[j][1][2], v[j][1][3]); o[64 * j] = w; }
        }
    }
}

__device__ __forceinline__ void p3_conv(Frame& F) {
    const int gw = F.vcu * NWAVES + F.wave, NGW = F.G * NWAVES;
    const bf16* U = (const bf16*)(F.ws + WS_U); const bf16* BG = (const bf16*)(F.ws + WS_BG); bf16* Y = (bf16*)(F.ws + WS_YB);
    const float* wd = arg_in(6);
    for (int it = gw; it < (T / 16) * 4; it += NGW) {
        const int strip = it >> 2, cq = it & 3, t0 = strip * 16, c0 = cq * 512 + F.lane * 8;
        float w0[8], w1[8], w2[8];
#pragma unroll
        for (int j = 0; j < 8; ++j) { w0[j] = wd[c0 + j]; w1[j] = wd[DM + c0 + j]; w2[j] = wd[2 * DM + c0 + j]; }
        float um2[8], um1[8];
        const bool first = (t0 % SEQ) == 0;
        if (first) {
#pragma unroll
            for (int j = 0; j < 8; ++j) { um2[j] = 0.f; um1[j] = 0.f; }
        } else {
            const v4u a = *(const v4u*)(U + (size_t)(t0 - 2) * DM + c0), b = *(const v4u*)(U + (size_t)(t0 - 1) * DM + c0);
            um2[0] = pg8::bf_lo(a.x); um2[1] = pg8::bf_hi(a.x); um2[2] = pg8::bf_lo(a.y); um2[3] = pg8::bf_hi(a.y); um2[4] = pg8::bf_lo(a.z); um2[5] = pg8::bf_hi(a.z); um2[6] = pg8::bf_lo(a.w); um2[7] = pg8::bf_hi(a.w);
            um1[0] = pg8::bf_lo(b.x); um1[1] = pg8::bf_hi(b.x); um1[2] = pg8::bf_lo(b.y); um1[3] = pg8::bf_hi(b.y); um1[4] = pg8::bf_lo(b.z); um1[5] = pg8::bf_hi(b.z); um1[6] = pg8::bf_lo(b.w); um1[7] = pg8::bf_hi(b.w);
        }
#pragma unroll 4
        for (int r = 0; r < 16; ++r) {
            const v4u a = *(const v4u*)(U + (size_t)(t0 + r) * DM + c0), g = *(const v4u*)(BG + (size_t)(t0 + r) * DM + c0);
            float u0[8], gg[8], y[8];
            u0[0] = pg8::bf_lo(a.x); u0[1] = pg8::bf_hi(a.x); u0[2] = pg8::bf_lo(a.y); u0[3] = pg8::bf_hi(a.y); u0[4] = pg8::bf_lo(a.z); u0[5] = pg8::bf_hi(a.z); u0[6] = pg8::bf_lo(a.w); u0[7] = pg8::bf_hi(a.w);
            gg[0] = pg8::bf_lo(g.x); gg[1] = pg8::bf_hi(g.x); gg[2] = pg8::bf_lo(g.y); gg[3] = pg8::bf_hi(g.y); gg[4] = pg8::bf_lo(g.z); gg[5] = pg8::bf_hi(g.z); gg[6] = pg8::bf_lo(g.w); gg[7] = pg8::bf_hi(g.w);
#pragma unroll
            for (int j = 0; j < 8; ++j) { y[j] = gg[j] * (w0[j] * um2[j] + w1[j] * um1[j] + w2[j] * u0[j]); um2[j] = um1[j]; um1[j] = u0[j]; }
            v4u o; o.x = pk2(y[0], y[1]); o.y = pk2(y[2], y[3]); o.z = pk2(y[4], y[5]); o.w = pk2(y[6], y[7]);
            *(v4u*)(Y + (size_t)(t0 + r) * DM + c0) = o;
        }
    }
}

__device__ __forceinline__ void norm_heads_row(bf16* row, const float* gain, int lane) {
    float g[8];
#pragma unroll
    for (int j = 0; j < 8; ++j) g[j] = gain[(lane & 15) * 8 + j];
#pragma unroll
    for (int q = 0; q < 4; ++q) {
        v4u* p = (v4u*)row + q * 64 + lane; const v4u a = *p;
        float v[8] = {pg8::bf_lo(a.x), pg8::bf_hi(a.x), pg8::bf_lo(a.y), pg8::bf_hi(a.y), pg8::bf_lo(a.z), pg8::bf_hi(a.z), pg8::bf_lo(a.w), pg8::bf_hi(a.w)};
        float s = 0.f;
#pragma unroll
        for (int j = 0; j < 8; ++j) s += v[j] * v[j];
        s += __shfl_xor(s, 1); s += __shfl_xor(s, 2); s += __shfl_xor(s, 4); s += __shfl_xor(s, 8);
        const float rs = 1.0f / sqrtf(s * (1.0f / HD) + RMS_EPS);
        v4u o; o.x = pk2(v[0] * rs * g[0], v[1] * rs * g[1]); o.y = pk2(v[2] * rs * g[2], v[3] * rs * g[3]); o.z = pk2(v[4] * rs * g[4], v[5] * rs * g[5]); o.w = pk2(v[6] * rs * g[6], v[7] * rs * g[7]);
        *p = o;
    }
}
__device__ __forceinline__ void p9_norms(Frame& F, const bf16* hb, const float* slots) {
    const int gw = F.vcu * NWAVES + F.wave, NGW = F.G * NWAVES;
    bf16* Q = (bf16*)(F.ws + WS_Q); bf16* K = (bf16*)(F.ws + WS_K);
    const float* Wf = (const float*)(F.ws + WS_WF); float* LF = (float*)(F.ws + WS_LF);
    for (int m = gw; m < T; m += NGW) {
        norm_heads_row(Q + (size_t)m * DM, arg_in(13), F.lane);
        norm_heads_row(K + (size_t)m * DM, arg_in(11), F.lane);
        float ssq = (F.lane < 32) ? slots[(size_t)m * 32 + F.lane] : 0.f; ssq = wave_sum(ssq);
        const float rstd = 1.0f / sqrtf(ssq * (1.0f / DM) + RMS_EPS);
        float xv[32];
#pragma unroll
        for (int q = 0; q < 4; ++q) { const v4u a = *((const v4u*)(hb + (size_t)m * DM) + q * 64 + F.lane);
            xv[8 * q + 0] = pg8::bf_lo(a.x); xv[8 * q + 1] = pg8::bf_hi(a.x); xv[8 * q + 2] = pg8::bf_lo(a.y); xv[8 * q + 3] = pg8::bf_hi(a.y);
            xv[8 * q + 4] = pg8::bf_lo(a.z); xv[8 * q + 5] = pg8::bf_hi(a.z); xv[8 * q + 6] = pg8::bf_lo(a.w); xv[8 * q + 7] = pg8::bf_hi(a.w); }
        float mine = 0.f;
        for (int h = 0; h < NH; ++h) {
            const float* wrow = Wf + (size_t)h * DM; float d = 0.f;
#pragma unroll
            for (int q = 0; q < 4; ++q) { const f32x4 w0 = *((const f32x4*)wrow + 2 * (q * 64 + F.lane)), w1 = *((const f32x4*)wrow + 2 * (q * 64 + F.lane) + 1);
                d += xv[8 * q + 0] * w0[0] + xv[8 * q + 1] * w0[1] + xv[8 * q + 2] * w0[2] + xv[8 * q + 3] * w0[3] + xv[8 * q + 4] * w1[0] + xv[8 * q + 5] * w1[1] + xv[8 * q + 6] * w1[2] + xv[8 * q + 7] * w1[3]; }
            d = wave_sum(d);
            if (F.lane == h) mine = d;
        }
        if (F.lane < NH) { const float f = rstd * mine + arg_in(10)[F.lane];
            const float ls = (f >= 0.f) ? -log1pf(expf(-f)) : f - log1pf(expf(f));
            LF[(size_t)m * NH + F.lane] = ls; }
    }
}
__device__ __forceinline__ void p10_scan(Frame& F) {
    const int gw = F.vcu * NWAVES + F.wave, NGW = F.G * NWAVES;
    const float* LF = (const float*)(F.ws + WS_LF); float* CB = (float*)(F.ws + WS_CB);
    for (int it = gw; it < NB * NH; it += NGW) {
        const int b = it / NH, h = it - b * NH; float v[32]; float run = 0.f;
#pragma unroll
        for (int j = 0; j < 32; ++j) { run += LF[((size_t)b * SEQ + 32 * F.lane + j) * NH + h]; v[j] = run; }
        float incl = run;
#pragma unroll
        for (int o = 1; o < 64; o <<= 1) { const float t = __shfl_up(incl, o); if (F.lane >= o) incl += t; }
        const float excl = incl - run;
        float* dst = CB + ((size_t)b * NH + h) * SEQ + 32 * F.lane;
#pragma unroll
        for (int j = 0; j < 32; j += 4) { f32x4 o4; o4[0] = -(excl + v[j]) * 11.313708498984761f; o4[1] = -(excl + v[j + 1]) * 11.313708498984761f; o4[2] = -(excl + v[j + 2]) * 11.313708498984761f; o4[3] = -(excl + v[j + 3]) * 11.313708498984761f; *(f32x4*)(dst + j) = o4; }
    }
}
struct RouteBufs { int* e; float* w; int* rank; int* row; int* hist; };
__device__ __forceinline__ RouteBufs route_bufs(unsigned char* ws) { RouteBufs r; unsigned char* b = ws + WS_ROUTE; r.e = (int*)b; r.w = (float*)(b + 65536); r.rank = (int*)(b + 131072); r.row = (int*)(b + 196608); r.hist = (int*)(b + 262144); return r; }
__device__ __forceinline__ void p13_route(Frame& F) {
    const float* h = F.out; const float* Wr = (const float*)(F.ws + WS_WR); float* rstd4 = (float*)(F.ws + WS_RSTD) + T;
    const RouteBufs R = route_bufs(F.ws);
    LAS int* le = (LAS int*)(F.lds + RING_OFF);
    for (int ch = F.vcu; ch < T / 32; ch += F.G) {
        for (int i = 0; i < 4; ++i) {
            const int tl = F.wave * 4 + i, m = ch * 32 + tl;
            const f32x4* xr = (const f32x4*)(h + (size_t)m * DM); float ss = 0.f; float lg[NE];
#pragma unroll
            for (int e = 0; e < NE; ++e) lg[e] = 0.f;
#pragma unroll
            for (int j = 0; j < 8; ++j) { const int c4 = j * 64 + F.lane; const f32x4 v = xr[c4];
                ss += (v[0] * v[0] + v[1] * v[1]) + (v[2] * v[2] + v[3] * v[3]);
                const f32x4* wp = (const f32x4*)(Wr + (size_t)c4 * 4 * NE);
#pragma unroll
                for (int q = 0; q < 4; ++q) { const f32x4 wa = wp[2 * q], wb = wp[2 * q + 1];
                    lg[0] += v[q] * wa[0]; lg[1] += v[q] * wa[1]; lg[2] += v[q] * wa[2]; lg[3] += v[q] * wa[3]; lg[4] += v[q] * wb[0]; lg[5] += v[q] * wb[1]; lg[6] += v[q] * wb[2]; lg[7] += v[q] * wb[3]; } }
            ss = wave_sum(ss);
#pragma unroll
            for (int e = 0; e < NE; ++e) lg[e] = wave_sum(lg[e]);
            const float rstd = 1.0f / sqrtf(ss * (1.0f / DM) + RMS_EPS);
            int e1 = 0; float v1 = lg[0];
#pragma unroll
            for (int e = 1; e < NE; ++e) if (lg[e] > v1) { v1 = lg[e]; e1 = e; }
            int e2 = -1; float v2 = -3.0e38f;
#pragma unroll
            for (int e = 0; e < NE; ++e) if (e != e1 && lg[e] > v2) { v2 = lg[e]; e2 = e; }
            const float w1 = 1.0f / (1.0f + expf((v2 - v1) * rstd)), w2 = 1.0f - w1;
            if (F.lane == 0) { rstd4[m] = rstd; R.e[2 * m] = e1; R.e[2 * m + 1] = e2; R.w[2 * m] = w1; R.w[2 * m + 1] = w2; le[2 * tl] = e1; le[2 * tl + 1] = e2; }
        }
        LDS_WAIT(); __syncthreads();
        if (F.wave == 0) { const int ei = le[F.lane]; int rank = 0;
#pragma unroll
            for (int e = 0; e < NE; ++e) { const unsigned long long mk = __ballot(ei == e); if (ei == e) rank = __popcll(mk & ((1ull << F.lane) - 1ull)); if (F.lane == 0) R.hist[ch * NE + e] = __popcll(mk); }
            R.rank[ch * 64 + F.lane] = rank; }
        __syncthreads();
    }
}
__device__ __forceinline__ void p14_gather(Frame& F, const bf16* hb) {
    const RouteBufs R = route_bufs(F.ws); const float* rstd4 = (const float*)(F.ws + WS_RSTD) + T;
    bf16* XG = (bf16*)(F.ws + WS_XG); float* rg = (float*)(F.ws + WS_RG); float* wrow = rg + MAXROWS;
    LAS int* sm = (LAS int*)(F.lds + RING_OFF + 1024);
    for (int ch = F.vcu; ch < T / 32; ch += F.G) {
        { const int e = F.wave; int below = 0, tot = 0;
#pragma unroll
            for (int q = 0; q < 4; ++q) { const int c2 = q * 64 + F.lane; const int v = R.hist[c2 * NE + e]; tot += v; below += (c2 < ch) ? v : 0; }
#pragma unroll
            for (int o = 1; o < 64; o <<= 1) { tot += __shfl_xor(tot, o); below += __shfl_xor(below, o); }
            if (F.lane == 0) { sm[e] = below; sm[8 + e] = tot; } }
        LDS_WAIT(); __syncthreads();
        if (F.tid == 0) { int s = 0; for (int e = 0; e < NE; ++e) { sm[16 + e] = s; s += (sm[8 + e] + 255) / 256 * 256; } }
        LDS_WAIT(); __syncthreads();
        for (int i = 0; i < 8; ++i) {
            const int tl = F.wave * 4 + (i >> 1), k = i & 1, m = ch * 32 + tl;
            const int e = R.e[2 * m + k]; const int dst = sm[16 + e] + sm[e] + R.rank[ch * 64 + 2 * tl + k];
            const v4u* src = (const v4u*)(hb + (size_t)m * DM); v4u* d = (v4u*)(XG + (size_t)dst * DM);
#pragma unroll
            for (int q = 0; q < 4; ++q) d[q * 64 + F.lane] = src[q * 64 + F.lane];
            if (F.lane == 0) { rg[dst] = rstd4[m]; wrow[dst] = R.w[2 * m + k]; R.row[2 * m + k] = dst; }
        }
        { const int e = F.wave, tot = sm[8 + e], padn = (256 - (tot & 255)) & 255;
          if (ch < padn) { const int dst = sm[16 + e] + tot + ch; v4u* d = (v4u*)(XG + (size_t)dst * DM); const v4u z = {0u, 0u, 0u, 0u};
#pragma unroll
              for (int q = 0; q < 4; ++q) d[q * 64 + F.lane] = z;
              if (F.lane == 0) { rg[dst] = 0.f; wrow[dst] = 0.f; } }
          if (ch == 0 && F.lane == 0) ((int*)(F.ws + WS_ROUTE + 300000))[e] = (tot + 255) / 256; }
        __syncthreads();
    }
}
__device__ __forceinline__ void p17_combine(Frame& F, bf16* hb) {
    const int gw = F.vcu * NWAVES + F.wave, NGW = F.G * NWAVES;
    const RouteBufs R = route_bufs(F.ws); const float* YM = (const float*)(F.ws + WS_YM); float* rstd5 = (float*)(F.ws + WS_RSTD) + 2 * T;
    for (int m = gw; m < T; m += NGW) {
        const int r0 = R.row[2 * m], r1 = R.row[2 * m + 1];
        f32x4* hr = (f32x4*)(F.out + (size_t)m * DM) + 2 * F.lane; const f32x4* y0 = (const f32x4*)(YM + (size_t)r0 * DM) + 2 * F.lane; const f32x4* y1 = (const f32x4*)(YM + (size_t)r1 * DM) + 2 * F.lane;
        float s = 0.f; v4u* o = (v4u*)(hb + (size_t)m * DM) + F.lane;
#pragma unroll
        for (int j = 0; j < 4; ++j) {
            f32x4 a = hr[128 * j] + y0[128 * j] + y1[128 * j], b = hr[128 * j + 1] + y0[128 * j + 1] + y1[128 * j + 1];
            hr[128 * j] = a; hr[128 * j + 1] = b;
            s += (a[0] * a[0] + a[1] * a[1]) + (a[2] * a[2] + a[3] * a[3]) + (b[0] * b[0] + b[1] * b[1]) + (b[2] * b[2] + b[3] * b[3]);
            v4u w; w.x = pk2(a[0], a[1]); w.y = pk2(a[2], a[3]); w.z = pk2(b[0], b[1]); w.w = pk2(b[2], b[3]); o[64 * j] = w; }
        s = wave_sum(s);
        if (F.lane == 0) rstd5[m] = 1.0f / sqrtf(s * (1.0f / DM) + RMS_EPS);
    }
}

#ifndef MK_PER_PHASE
#define MK_PER_PHASE 0
#endif
constexpr int NPHASE = 19;
struct Args { const float* in[22]; float* out; unsigned char* ws; int ph_lo, ph_hi; };
static_assert(sizeof(Args) == 24 * 8 + 8, "Args has no padding");

__global__ void __launch_bounds__(NWAVES * 64, 2) yoco_fwd(Args args) {
    extern __shared__ __attribute__((aligned(16))) unsigned char lds[];
    Frame F;
    F.lds = (LAS unsigned char*)lds;
    F.MISC = (volatile LAS unsigned*)(F.lds + MISC_OFF);
    F.tab = (LAS float*)(F.lds + TAB_OFF);
    F.tid = threadIdx.x; F.lane = F.tid & 63; F.wave = __builtin_amdgcn_readfirstlane(F.tid >> 6);
    F.G = gridDim.x; { const int bx = blockIdx.x; F.vcu = (F.G % 8 == 0) ? (bx % 8) * (F.G / 8) + bx / 8 : bx; }
    unsigned char* ws = args.ws; F.ws = ws; F.out = args.out;
    F.ctl = (gu32*)(ws + WS_CTL);
    for (int u = F.tid; u < (LDS_BYTES - MISC_OFF) / 4; u += NWAVES * 64) ((LAS unsigned*)(F.lds + MISC_OFF))[u] = 0u;
    __syncthreads();
    XcdBarrier bar; bar.bar = (unsigned*)(F.ctl + CW_BAR); bar.x = 0; bar.st = nullptr;
    if (!MK_PER_PHASE) bar = xcd_barrier_post((unsigned*)(F.ctl + CW_BAR), F.MISC + 8);
    const int lo = args.ph_lo, hi = args.ph_hi;
#ifndef PHMASK
#define PHMASK 0xFFFFFFFFu
#endif
#define IN(k) (((PHMASK >> (k)) & 1u) && lo <= (k) && (k) < hi)
#define SEAM(k) do { if (IN(k) && IN((k) + 1)) xcd_barrier(bar); } while (0)
    const LAS float* tabc = (const LAS float*)F.tab;
    bf16* HB = (bf16*)(ws + WS_HB); bf16* HB2 = (bf16*)(ws + WS_HB2);
    float* rstd0 = (float*)(ws + WS_RSTD); float* rstd5 = rstd0 + 2 * T;
    float* SL1 = (float*)(ws + WS_SL1); float* SL2 = (float*)(ws + WS_SL2); float* SL3 = (float*)(ws + WS_SL3);
    const int cid = (int)blockIdx.x;
    using pg8::Gemm; using pg8::StaticOrder; using pg8::GroupedOrder; using pg8::RsNone; using pg8::RsDirect; using pg8::RsSlots;

    if (IN(0)) { p0_prologue(F); } SEAM(0);
    if (IN(1)) {
        const int rt2[NE] = {T / 256, T / 256, 0, 0, 0, 0, 0, 0};
        Gemm g{(const bf16*)(ws + WS_PB), (const bf16*)(ws + WS_WPU), 2 * T, DM, PLE};
        GroupedOrder<RsNone> S; S.init(rt2, DM / 256, F.G, cid);
        pg8::EpiBf16S<false> E{(bf16*)(ws + WS_E0), DM, 0, 0, tabc};
        pg8::gemm_phase<pg8::EpiBf16S<false>, GroupedOrder<RsNone>, true, true>(F.lds + RING_OFF, g, S, E);
    } SEAM(1);
    if (IN(2)) {
        Gemm g{HB, (const bf16*)(ws + WS_WCI), T, 3 * DM, DM};
        StaticOrder<RsDirect> S; S.init(T, 3 * DM, F.G, cid); S.rs = RsDirect{rstd0, F.tab};
        pg8::EpiPair<0, true> E{(bf16*)(ws + WS_U), DM, 16, (bf16*)(ws + WS_BG), DM, tabc};
        pg8::gemm_phase<pg8::EpiPair<0, true>, StaticOrder<RsDirect>, true, true>(F.lds + RING_OFF, g, S, E);
    } SEAM(2);
    if (IN(3)) { p3_conv(F); } SEAM(3);
    if (IN(4)) {
        Gemm g{(const bf16*)(ws + WS_YB), (const bf16*)(ws + WS_WCO), T, DM, DM};
        StaticOrder<RsNone> S; S.init(T, DM, F.G, cid);
        pg8::EpiResid<0> E{arg_in(0), F.out, HB2, SL1, nullptr, tabc};
        pg8::gemm_phase<pg8::EpiResid<0>, StaticOrder<RsNone>, true, true>(F.lds + RING_OFF, g, S, E);
    } SEAM(4);
    if (IN(5)) {
        Gemm g{HB2, (const bf16*)(ws + WS_WGU), T, 2 * DFF, DM};
        StaticOrder<RsSlots> S; S.init(T, 2 * DFF, F.G, cid); S.rs = RsSlots{SL1, F.tab};
        pg8::EpiPair<1, false> E{(bf16*)(ws + WS_ACT), DFF, 1 << 30, nullptr, 0, tabc};
        pg8::gemm_phase<pg8::EpiPair<1, false>, StaticOrder<RsSlots>, true, true>(F.lds + RING_OFF, g, S, E);
    } SEAM(5);
    if (IN(6)) {
        Gemm g{(const bf16*)(ws + WS_ACT), (const bf16*)(ws + WS_WFD), T, DM, DFF};
        StaticOrder<RsNone> S; S.init(T, DM, F.G, cid);
        pg8::EpiResid<0> E{F.out, F.out, HB, SL2, nullptr, tabc};
        pg8::gemm_phase<pg8::EpiResid<0>, StaticOrder<RsNone>, true, true>(F.lds + RING_OFF, g, S, E);
    } SEAM(6);
    if (IN(7)) {
        Gemm g{HB, (const bf16*)(ws + WS_WPG), T, DM, DM};
        StaticOrder<RsSlots> S; S.init(T, DM, F.G, cid); S.rs = RsSlots{SL2, F.tab};
        pg8::EpiResid<1> E{F.out, F.out, HB2, SL3, (const bf16*)(ws + WS_E0), tabc};
        pg8::gemm_phase<pg8::EpiResid<1>, StaticOrder<RsSlots>, true, true>(F.lds + RING_OFF, g, S, E);
    } SEAM(7);
    if (IN(8)) {
        Gemm g{HB2, (const bf16*)(ws + WS_WQKV), T, 3 * DM, DM};
        StaticOrder<RsSlots> S; S.init(T, 3 * DM, F.G, cid); S.rs = RsSlots{SL3, F.tab};
        pg8::EpiBf16S<true> E{(bf16*)(ws + WS_Q), DM, DM, (size_t)(WS_K - WS_Q) / 2, tabc};
        pg8::gemm_phase<pg8::EpiBf16S<true>, StaticOrder<RsSlots>, true, true>(F.lds + RING_OFF, g, S, E);
    } SEAM(8);
    if (IN(9)) { p9_norms(F, HB2, SL3); } SEAM(9);
    if (IN(10)) { p10_scan(F); } SEAM(10);
    if (IN(11)) {
        const fox::Ptrs P{(const fox::bf16*)(ws + WS_Q), (const fox::bf16*)(ws + WS_K), (const fox::bf16*)(ws + WS_V), (fox::bf16*)(ws + WS_O), (const float*)(ws + WS_CB)};
        const int total = NB * NH * 4;
        int L = F.vcu;
        if (L < total) {
            int pass = 0, par = 0; fox::BlockRef cur = fox::mk_ref(L, 0); fox::Seam S;
            fox::fox_prime(P, cur, (char*)lds + RING_OFF, S);
            for (;;) {
                const bool more_pass = pass == 0, more_item = L + F.G < total, last = !more_pass && !more_item;
                int Ln = L, passn = pass + 1; if (!more_pass) { passn = 0; Ln = more_item ? L + F.G : L; }
                const fox::BlockRef nxt = last ? cur : fox::mk_ref(Ln, passn);
                fox::fox_block(P, cur, nxt, par, (char*)lds + RING_OFF, S);
                if (last) break;
                cur = nxt; pass = passn; L = Ln; par ^= 1;
            }
        }
    } SEAM(11);
    if (IN(12)) {
        Gemm g{(const bf16*)(ws + WS_O), (const bf16*)(ws + WS_WO), T, DM, DM};
        StaticOrder<RsNone> S; S.init(T, DM, F.G, cid);
        pg8::EpiResid<0> E{F.out, F.out, HB, nullptr, nullptr, tabc};
        pg8::gemm_phase<pg8::EpiResid<0>, StaticOrder<RsNone>, true, true>(F.lds + RING_OFF, g, S, E);
    } SEAM(12);
    if (IN(13)) { p13_route(F); } SEAM(13);
    if (IN(14)) { p14_gather(F, HB); } SEAM(14);
    int rts[NE];
    if (IN(15) || IN(16)) {
        const int* rp = (const int*)(ws + WS_ROUTE + 300000);
#pragma unroll
        for (int e = 0; e < NE; ++e) rts[e] = __builtin_amdgcn_readfirstlane((int)__hip_atomic_load((unsigned*)rp + e, RLX_AGENT));
    }
    if (IN(15)) {
        Gemm g{(const bf16*)(ws + WS_XG), (const bf16*)(ws + WS_WMGU), MAXROWS, 2 * DFE, DM};
        GroupedOrder<RsDirect> S; S.init(rts, 2 * DFE / 256, F.G, cid); S.rs = RsDirect{(const float*)(ws + WS_RG), F.tab};
        pg8::EpiPair<1, false> E{(bf16*)(ws + WS_ACTM), DFE, 1 << 30, nullptr, 0, tabc};
        pg8::gemm_phase<pg8::EpiPair<1, false>, GroupedOrder<RsDirect>, true, true>(F.lds + RING_OFF, g, S, E);
    } SEAM(15);
    if (IN(16)) {
        Gemm g{(const bf16*)(ws + WS_ACTM), (const bf16*)(ws + WS_WMD), MAXROWS, DM, DFE};
        GroupedOrder<RsDirect> S; S.init(rts, DM / 256, F.G, cid); S.rs = RsDirect{(const float*)(ws + WS_RG) + MAXROWS, F.tab};
        pg8::EpiF32S E{(float*)(ws + WS_YM), DM, tabc};
        pg8::gemm_phase<pg8::EpiF32S, GroupedOrder<RsDirect>, true, true>(F.lds + RING_OFF, g, S, E);
    } SEAM(16);
    if (IN(17)) { p17_combine(F, HB2); } SEAM(17);
    if (IN(18)) {
        Gemm g{HB2, (const bf16*)(ws + WS_WPG) + (size_t)DM * DM, T, DM, DM};
        StaticOrder<RsDirect> S; S.init(T, DM, F.G, cid); S.rs = RsDirect{rstd5, F.tab};
        pg8::EpiResid<1> E{F.out, F.out, nullptr, nullptr, (const bf16*)(ws + WS_E1), tabc};
        pg8::gemm_phase<pg8::EpiResid<1>, StaticOrder<RsDirect>, true, true>(F.lds + RING_OFF, g, S, E);
    }
#undef IN
#undef SEAM
}

extern "C" void kernel_launch(void* const* d_in, const int* in_sizes, int n_in, void* d_out, int out_size, void* d_ws, size_t ws_size, hipStream_t stream) {
    static int grid = 0;
    if (grid == 0) {
        if (n_in != 22 || out_size != T * DM || ws_size < WS_END) { fprintf(stderr, "kernel_launch: unexpected shapes (n_in %d out %d ws %zu need %zu)\n", n_in, out_size, ws_size, (size_t)WS_END); grid = -1; return; }
        int dev = 0, cus = 0, per_cu = 0;
        if (hipGetDevice(&dev) != hipSuccess || hipDeviceGetAttribute(&cus, hipDeviceAttributeMultiprocessorCount, dev) != hipSuccess) { grid = -1; return; }
        if (hipFuncSetAttribute((const void*)yoco_fwd, hipFuncAttributeMaxDynamicSharedMemorySize, LDS_BYTES) != hipSuccess) { fprintf(stderr, "kernel_launch: hipFuncSetAttribute failed\n"); grid = -1; return; }
        if (hipOccupancyMaxActiveBlocksPerMultiprocessor(&per_cu, (const void*)yoco_fwd, NWAVES * 64, LDS_BYTES) != hipSuccess || per_cu < 1) { fprintf(stderr, "kernel_launch: occupancy query says %d\n", per_cu); }
        (void)hipGetLastError();
        grid = cus;
    }
    if (grid < 0) return;
    (void)hipMemsetAsync((char*)d_ws + WS_CTL, 0, CTL_ZERO_BYTES, stream);
    Args a{};
    for (int i = 0; i < 22; ++i) a.in[i] = (const float*)d_in[i];
    a.out = (float*)d_out; a.ws = (unsigned char*)d_ws;
#if MK_PER_PHASE
    for (int p = 0; p < NPHASE; ++p) { a.ph_lo = p; a.ph_hi = p + 1; hipLaunchKernelGGL(yoco_fwd, dim3(grid), dim3(NWAVES * 64), LDS_BYTES, stream, a); }
#else
    a.ph_lo = 0; a.ph_hi = NPHASE;
    hipLaunchKernelGGL(yoco_fwd, dim3(grid), dim3(NWAVES * 64), LDS_BYTES, stream, a);
#endif
    const hipError_t le = hipPeekAtLastError();
    if (le != hipSuccess) fprintf(stderr, "kernel_launch: launch failed: %s\n", hipGetErrorName(le));
}
```

```cpp
#include <hip/hip_runtime.h>
#include <hip/hip_bf16.h>
#include <cstdio>
#include <cstdint>

#define LAS __attribute__((address_space(3)))
#define GAS __attribute__((address_space(1)))

#ifndef FP8_WO
#define FP8_WO true
#endif
constexpr int DM = 2048, NB = 4, SEQ = 2048, T = NB * SEQ, NH = 16, HD = 128;
constexpr int DFF = 5632, NE = 8, DFE = 7168, PLE = 256;
constexpr float RMS_EPS = 1e-6f;
constexpr int MAXRT = 72;
constexpr int MAXROWS = MAXRT * 256;

namespace pg8 {
typedef unsigned short bf16_t;
typedef short bf16x8 __attribute__((ext_vector_type(8)));
typedef float f32x4 __attribute__((ext_vector_type(4)));
typedef unsigned u32x4 __attribute__((ext_vector_type(4)));
constexpr int BM = 256, BK = 64, HALF = 128, HTB = HALF * BK * 2, STAGE_BYTES = 8 * HTB, NXCD = 8, WGM = 4;

__host__ __device__ __forceinline__ int lds_byte(int r, int c) { const int st = (r >> 4) * 2 + (c >> 5), rr = r & 15, cc = c & 31, ob = rr * 64 + cc * 2; return st * 1024 + (ob ^ (((ob >> 9) & 1) << 5)); }
__host__ __device__ __forceinline__ void stage_rc(int b, int& R, int& C) { const int st = b / 1024, sb = b % 1024, swz = sb ^ (((sb >> 9) & 1) << 5); R = (st >> 1) * 16 + swz / 64; C = (st & 1) * 32 + (swz % 64) / 2; }
__host__ __device__ __forceinline__ int perm32(int rho) { const int n = rho >> 4, i = rho & 15; return 8 * (i >> 2) + 4 * n + (i & 3); }

struct Unit { int pm, pn, aux, par; };
struct Gemm { const bf16_t* A; const bf16_t* Bt; int M, N, K; int Kp = 0; };

struct RsNone { __device__ __forceinline__ void fill(const Unit&) const {} };
struct RsDirect { const float* src; LAS float* tab;
    __device__ __forceinline__ void fill(const Unit& u) const { int t = threadIdx.x; asm volatile("" : "+v"(t));
        if (t < 256) tab[u.par * 256 + t] = src[(size_t)u.pm * 256 + t]; } };
struct RsSlots { const float* slots; LAS float* tab; float mul;
    __device__ __forceinline__ void fill(const Unit& u) const {
        int t = threadIdx.x; asm volatile("" : "+v"(t));
        const int row = t >> 1, hf = t & 1; const f32x4* p = (const f32x4*)(slots + ((size_t)u.pm * 256 + row) * 32 + hf * 16);
        const f32x4 a = p[0], b = p[1], c = p[2], d = p[3];
        float s = ((a[0] + a[1]) + (a[2] + a[3])) + ((b[0] + b[1]) + (b[2] + b[3])) + ((c[0] + c[1]) + (c[2] + c[3])) + ((d[0] + d[1]) + (d[2] + d[3]));
        s += __shfl_xor(s, 1);
        if (hf == 0) tab[u.par * 256 + row] = mul / sqrtf(s * (1.0f / DM) + RMS_EPS);
    } };

template <class RS> struct StaticOrder {
    int nM, nN, nwg, G, c, i0, iend; RS rs;
    __device__ __forceinline__ void init(int M, int N, int G_, int c_) { nM = M / BM; nN = N / BM; nwg = nM * nN; G = G_; c = c_; i0 = 0; iend = 1 << 24; }
    __device__ __forceinline__ bool next(int i, Unit& u) const {
        if (i + i0 >= iend) return false;
        const long L = (long)(i + i0) * G + c; if (L >= nwg) return false;
        int wgid = (int)L; { const int q = nwg / NXCD, r = nwg % NXCD, xcd = wgid % NXCD, off = wgid / NXCD; wgid = (xcd < r ? xcd * (q + 1) : r * (q + 1) + (xcd - r) * q) + off; }
        const int nig = WGM * nN, gid = wgid / nig, fm = gid * WGM, gsz = (nM - fm) < WGM ? (nM - fm) : WGM;
        u.pm = fm + ((wgid % nig) % gsz); u.pn = (wgid % nig) / gsz; u.aux = u.pn; u.par = i & 1; return true;
    }
    __device__ __forceinline__ void a_ready(const Unit& u) const { rs.fill(u); }
    __device__ __forceinline__ void done(const Unit&) const {}
};
template <class RS, bool PNFAST = false> struct GroupedOrder {
    int rt[NE]; int NT, G, c, nwg, nlim, i0 = 0, iend = 1 << 24; RS rs;
    __device__ __forceinline__ void init(const int* rts, int NT_, int G_, int c_) { int s = 0;
#pragma unroll
        for (int e = 0; e < NE; ++e) { rt[e] = rts[e]; s += rts[e]; } NT = NT_; G = G_; c = c_; nwg = s * NT_; nlim = nwg; }
    __device__ __forceinline__ void decode(int L, Unit& u) const {
        int wgid = L; { const int q = nwg / NXCD, r = nwg % NXCD, xcd = wgid % NXCD, off = wgid / NXCD; wgid = (xcd < r ? xcd * (q + 1) : r * (q + 1) + (xcd - r) * q) + off; }
        int e = 0, rbase = 0, w = wgid;
#pragma unroll
        for (int k = 0; k < NE - 1; ++k) { const int sz = rt[k] * NT; if (e == k && w >= sz) { w -= sz; rbase += rt[k]; e = k + 1; } }
        int rte = rt[0];
#pragma unroll
        for (int k = 1; k < NE; ++k) rte = (e == k) ? rt[k] : rte;
        int pn, rl; if (PNFAST) { rl = w / NT; pn = w - rl * NT; } else { pn = w / rte; rl = w - pn * rte; }
        u.pm = rbase + rl; u.pn = e * NT + pn; u.aux = pn;
    }
    __device__ __forceinline__ bool next(int i, Unit& u) const {
        if (i + i0 >= iend) return false;
        const long L = (long)(i + i0) * G + c; if (L >= nlim) return false;
        decode((int)L, u); u.par = i & 1; return true;
    }
    __device__ __forceinline__ void a_ready(const Unit& u) const { rs.fill(u); }
    __device__ __forceinline__ void done(const Unit&) const {}
};

struct OneUnit { Unit u;
    __device__ __forceinline__ bool next(int i, Unit& o) const { if (i != 0) return false; o = u; return true; }
    __device__ __forceinline__ void a_ready(const Unit&) const {}
    __device__ __forceinline__ void done(const Unit&) const {}
};
struct PanelOrder { int x, r, W, rtl;
    __device__ __forceinline__ bool next(int i, Unit& u) const { const int j = i * W + r; if (j >= 64) return false;
        const int layer = j >> 5, t4 = (j >> 3) & 3, c8 = j & 7; u.pm = layer * rtl + 4 * x + t4; u.pn = layer * 8 + c8; u.aux = c8; u.par = i & 1; return true; }
    __device__ __forceinline__ void a_ready(const Unit&) const {}
    __device__ __forceinline__ void done(const Unit&) const {}
};

__device__ __forceinline__ unsigned cvt_pk_bf16(float lo, float hi) { unsigned r; asm volatile("v_cvt_pk_bf16_f32 %0, %1, %2" : "=v"(r) : "v"(lo), "v"(hi)); return r; }
__device__ __forceinline__ u32x4 pack8(const f32x4 a, const f32x4 b) { u32x4 w; w.x = cvt_pk_bf16(a[0], a[1]); w.y = cvt_pk_bf16(a[2], a[3]); w.z = cvt_pk_bf16(b[0], b[1]); w.w = cvt_pk_bf16(b[2], b[3]); return w; }
typedef int i32x4 __attribute__((ext_vector_type(4)));
typedef int i32x8 __attribute__((ext_vector_type(8)));
__device__ __forceinline__ i32x8 cat16(const bf16x8 a, const bf16x8 b) { const i32x4 x = __builtin_bit_cast(i32x4, a), y = __builtin_bit_cast(i32x4, b); return __builtin_shufflevector(x, y, 0, 1, 2, 3, 4, 5, 6, 7); }
__device__ __forceinline__ void mfma_f8(f32x4& acc, const i32x8 b, const i32x8 a) { asm volatile("v_mfma_f32_16x16x128_f8f6f4 %0, %1, %2, %0" : "+v"(acc) : "v"(b), "v"(a)); }
__device__ __forceinline__ float clamp8(float v) { return __builtin_amdgcn_fmed3f(v, -448.0f, 448.0f); }
__device__ __forceinline__ unsigned pk4_fp8(float a, float b, float c, float d) { int w = 0; w = __builtin_amdgcn_cvt_pk_fp8_f32(clamp8(a), clamp8(b), w, false); w = __builtin_amdgcn_cvt_pk_fp8_f32(clamp8(c), clamp8(d), w, true); return (unsigned)w; }
__device__ __forceinline__ float bf_lo(unsigned w) { return __uint_as_float(w << 16); }
__device__ __forceinline__ float bf_hi(unsigned w) { return __uint_as_float(w & 0xffff0000u); }
__device__ __forceinline__ float sigmoidf_(float z) { return __builtin_amdgcn_rcpf(1.0f + __builtin_amdgcn_exp2f(-1.4426950408889634f * z)); }


template <bool SCALE> struct EpiBf16S {
    static constexpr bool PERM = true, AFTER_DRAIN = false;
    bf16_t* O; int ldc; int split_cols; size_t split_stride; const LAS float* tab; float cs;
    __device__ __forceinline__ void operator()(const f32x4 (&acc)[2][2][4][2], const Unit& u, int wr, int wc, int fr, int fq) const {
        int colt = u.aux * BM; bf16_t* base = O;
        if (split_cols) { const int t = colt / split_cols; base += (size_t)t * split_stride; colt -= t * split_cols; }
        const int col0 = colt + wc * 32 + 8 * fq;
#pragma unroll
        for (int ai = 0; ai < 2; ++ai)
#pragma unroll
            for (int m = 0; m < 4; ++m) { const int r = ai * HALF + wr * 64 + m * 16 + fr; const float s = SCALE ? tab[u.par * 256 + r] : cs;
                bf16_t* rowp = base + (size_t)(u.pm * BM + r) * ldc + col0;
#pragma unroll
                for (int bj = 0; bj < 2; ++bj) *(u32x4*)(rowp + bj * HALF) = pack8(acc[ai][bj][m][0] * s, acc[ai][bj][m][1] * s); }
    }
};
struct EpiSlab {
    static constexpr bool PERM = true, AFTER_DRAIN = false;
    bf16_t* O; float cs;
    __device__ __forceinline__ void operator()(const f32x4 (&acc)[2][2][4][2], const Unit&, int wr, int wc, int fr, int fq) const {
#pragma unroll
        for (int ai = 0; ai < 2; ++ai)
#pragma unroll
            for (int m = 0; m < 4; ++m) { const int r = ai * HALF + wr * 64 + m * 16 + fr;
#pragma unroll
                for (int bj = 0; bj < 2; ++bj) *(u32x4*)(O + r * BM + bj * HALF + wc * 32 + 8 * fq) = pack8(acc[ai][bj][m][0] * cs, acc[ai][bj][m][1] * cs); }
    }
};
struct EpiQKV {
    static constexpr bool PERM = true, AFTER_DRAIN = false;
    bf16_t* Q; bf16_t* K; bf16_t* V; const float* qg; const float* kg; const LAS float* tab; LAS float* red;
    __device__ __forceinline__ void operator()(const f32x4 (&acc)[2][2][4][2], const Unit& u, int wr, int wc, int fr, int fq) const {
        const int which = u.aux >> 3, pnl = u.aux & 7, dcol = wc * 32 + 8 * fq;
        f32x4 g0 = {1.f, 1.f, 1.f, 1.f}, g1 = {1.f, 1.f, 1.f, 1.f};
        if (which < 2) {
            const float* gp = (which == 0 ? qg : kg) + dcol; g0 = *(const f32x4*)gp; g1 = *(const f32x4*)(gp + 4);
#pragma unroll
            for (int ai = 0; ai < 2; ++ai)
#pragma unroll
                for (int m = 0; m < 4; ++m) { const int r = ai * HALF + wr * 64 + m * 16 + fr; const float s = tab[u.par * 256 + r];
#pragma unroll
                    for (int bj = 0; bj < 2; ++bj) { const f32x4 a = acc[ai][bj][m][0] * s, b = acc[ai][bj][m][1] * s;
                        float p = (a[0] * a[0] + a[1] * a[1]) + (a[2] * a[2] + a[3] * a[3]) + (b[0] * b[0] + b[1] * b[1]) + (b[2] * b[2] + b[3] * b[3]);
                        p += __shfl_xor(p, 16); p += __shfl_xor(p, 32);
                        if (fq == 0) red[r * 8 + bj * 4 + wc] = p; } }
            asm volatile("s_waitcnt lgkmcnt(0)" ::: "memory"); __builtin_amdgcn_s_barrier(); asm volatile("" ::: "memory");
        }
#pragma unroll
        for (int ai = 0; ai < 2; ++ai)
#pragma unroll
            for (int m = 0; m < 4; ++m) { const int r = ai * HALF + wr * 64 + m * 16 + fr; const int t = u.pm * BM + r; const float s = tab[u.par * 256 + r];
#pragma unroll
                for (int bj = 0; bj < 2; ++bj) { const int h = 2 * pnl + bj; float f = s;
                    if (which < 2) { const f32x4 q = *(const LAS f32x4*)(red + r * 8 + bj * 4); f *= 1.0f / sqrtf(((q[0] + q[1]) + (q[2] + q[3])) * (1.0f / HD) + RMS_EPS); }
                    const u32x4 w = pack8(acc[ai][bj][m][0] * f * g0, acc[ai][bj][m][1] * f * g1);
                    if (which == 0) *(u32x4*)(Q + (size_t)t * DM + h * HD + dcol) = w;
                    else { const int b = t / SEQ, sq = t - b * SEQ; *(u32x4*)((which == 1 ? K : V) + ((size_t)(b * NH + h) * SEQ + sq) * HD + dcol) = w; } } }
    }
};
template <int MODE, bool HASPLAIN, bool OUT8 = false, bool ROWTAB = true> struct EpiPair {
    static constexpr bool PERM = true, AFTER_DRAIN = false;
    bf16_t* O; int ldc; int npair; bf16_t* O2; int ldc2; const LAS float* tab; float oscale; float cscale;
    __device__ __forceinline__ void operator()(const f32x4 (&acc)[2][2][4][2], const Unit& u, int wr, int wc, int fr, int fq) const {
        if (!HASPLAIN || u.aux < npair) {
            const int col0 = u.aux * HALF + wc * 32 + 8 * fq;
#pragma unroll
            for (int ai = 0; ai < 2; ++ai)
#pragma unroll
                for (int m = 0; m < 4; ++m) { const int r = ai * HALF + wr * 64 + m * 16 + fr; const float s = ROWTAB ? tab[u.par * 256 + r] : cscale;
                    f32x4 o[2];
#pragma unroll
                    for (int n = 0; n < 2; ++n) { const f32x4 a = acc[ai][0][m][n] * s, b = acc[ai][1][m][n] * s;
                        if (MODE == 0) o[n] = a * b;
                        else {
#pragma unroll
                            for (int j = 0; j < 4; ++j) o[n][j] = a[j] * sigmoidf_(a[j]) * b[j]; } }
                    if constexpr (OUT8) { typedef unsigned u32x2 __attribute__((ext_vector_type(2))); u32x2 w; o[0] *= oscale; o[1] *= oscale;
                        w.x = pk4_fp8(o[0][0], o[0][1], o[0][2], o[0][3]); w.y = pk4_fp8(o[1][0], o[1][1], o[1][2], o[1][3]);
                        *(u32x2*)((unsigned char*)O + (size_t)(u.pm * BM + r) * ldc + col0) = w; }
                    else *(u32x4*)(O + (size_t)(u.pm * BM + r) * ldc + col0) = pack8(o[0], o[1]); }
        } else if (HASPLAIN) {
            const int col0 = (u.aux - npair) * BM + wc * 32 + 8 * fq;
#pragma unroll
            for (int ai = 0; ai < 2; ++ai)
#pragma unroll
                for (int m = 0; m < 4; ++m) { const int r = ai * HALF + wr * 64 + m * 16 + fr; const float s = tab[u.par * 256 + r];
                    bf16_t* rowp = O2 + (size_t)(u.pm * BM + r) * ldc2 + col0;
#pragma unroll
                    for (int bj = 0; bj < 2; ++bj) *(u32x4*)(rowp + bj * HALF) = pack8(acc[ai][bj][m][0] * s, acc[ai][bj][m][1] * s); }
        }
    }
};
template <int MODE, bool HIN_F32, bool OUT_F32, bool CSCALE = false> struct EpiResid {
    static constexpr bool PERM = true, AFTER_DRAIN = false;
    const void* hin; void* hout; float* slots; const bf16_t* E; const LAS float* tab; unsigned char* h8; float h8scale; float ascale;
    __device__ __forceinline__ void operator()(const f32x4 (&acc)[2][2][4][2], const Unit& u, int wr, int wc, int fr, int fq) const {
        const int col0 = u.aux * BM + wc * 32 + 8 * fq;
        constexpr int MB = (MODE == 0 && HIN_F32) ? 2 : 4;
#pragma unroll
        for (int ai = 0; ai < 2; ++ai)
#pragma unroll
            for (int m0 = 0; m0 < 4; m0 += MB) {
                f32x4 pre[MB][2][2]; u32x4 pb[MB][2], pe[MB][2];
#pragma unroll
                for (int mm = 0; mm < MB; ++mm) { const int r = ai * HALF + wr * 64 + (m0 + mm) * 16 + fr; const size_t off = (size_t)(u.pm * BM + r) * DM + col0;
#pragma unroll
                    for (int bj = 0; bj < 2; ++bj) {
                        if (HIN_F32) { pre[mm][bj][0] = *(const f32x4*)((const float*)hin + off + bj * HALF); pre[mm][bj][1] = *(const f32x4*)((const float*)hin + off + bj * HALF + 4); }
                        else pb[mm][bj] = *(const u32x4*)((const bf16_t*)hin + off + bj * HALF);
                        if (MODE == 1) pe[mm][bj] = *(const u32x4*)(E + off + bj * HALF); } }
#pragma unroll
                for (int mm = 0; mm < MB; ++mm) { const int m = m0 + mm; const int r = ai * HALF + wr * 64 + m * 16 + fr; const size_t off = (size_t)(u.pm * BM + r) * DM + col0;
                    float s = 1.0f; if (MODE == 1) s = CSCALE ? ascale : tab[u.par * 256 + r];
                    float ss = 0.f;
#pragma unroll
                    for (int bj = 0; bj < 2; ++bj) {
                        f32x4 v0, v1;
                        if (HIN_F32) { v0 = pre[mm][bj][0]; v1 = pre[mm][bj][1]; }
                        else { const u32x4 h = pb[mm][bj]; v0 = (f32x4){bf_lo(h.x), bf_hi(h.x), bf_lo(h.y), bf_hi(h.y)}; v1 = (f32x4){bf_lo(h.z), bf_hi(h.z), bf_lo(h.w), bf_hi(h.w)}; }
                        if (MODE == 0) { v0 += acc[ai][bj][m][0] * ascale; v1 += acc[ai][bj][m][1] * ascale; }
                        else { const u32x4 e = pe[mm][bj]; const f32x4 a0 = acc[ai][bj][m][0] * s, a1 = acc[ai][bj][m][1] * s;
                            v0[0] += sigmoidf_(a0[0]) * bf_lo(e.x); v0[1] += sigmoidf_(a0[1]) * bf_hi(e.x); v0[2] += sigmoidf_(a0[2]) * bf_lo(e.y); v0[3] += sigmoidf_(a0[3]) * bf_hi(e.y);
                            v1[0] += sigmoidf_(a1[0]) * bf_lo(e.z); v1[1] += sigmoidf_(a1[1]) * bf_hi(e.z); v1[2] += sigmoidf_(a1[2]) * bf_lo(e.w); v1[3] += sigmoidf_(a1[3]) * bf_hi(e.w); }
                        if (OUT_F32) { *(f32x4*)((float*)hout + off + bj * HALF) = v0; *(f32x4*)((float*)hout + off + bj * HALF + 4) = v1; }
                        else *(u32x4*)((bf16_t*)hout + off + bj * HALF) = pack8(v0, v1);
                        if (h8) { typedef unsigned u32x2 __attribute__((ext_vector_type(2))); u32x2 w; w.x = pk4_fp8(v0[0] * h8scale, v0[1] * h8scale, v0[2] * h8scale, v0[3] * h8scale); w.y = pk4_fp8(v1[0] * h8scale, v1[1] * h8scale, v1[2] * h8scale, v1[3] * h8scale); *(u32x2*)(h8 + off + bj * HALF) = w; }
                        ss += (v0[0] * v0[0] + v0[1] * v0[1]) + (v0[2] * v0[2] + v0[3] * v0[3]) + (v1[0] * v1[0] + v1[1] * v1[1]) + (v1[2] * v1[2] + v1[3] * v1[3]);
                    }
                    if (slots) { ss += __shfl_xor(ss, 16); ss += __shfl_xor(ss, 32); if (fq == 0) slots[(size_t)(u.pm * BM + r) * 32 + u.aux * 4 + wc] = ss; }
                }
                asm volatile("" ::: "memory");
            }
    }
};
struct EpiF32S {
    static constexpr bool PERM = true, AFTER_DRAIN = false;
    float* O; int ldc; const LAS float* tab;
    __device__ __forceinline__ void operator()(const f32x4 (&acc)[2][2][4][2], const Unit& u, int wr, int wc, int fr, int fq) const {
        const int col0 = u.aux * BM + wc * 32 + 8 * fq;
#pragma unroll
        for (int ai = 0; ai < 2; ++ai)
#pragma unroll
            for (int m = 0; m < 4; ++m) { const int r = ai * HALF + wr * 64 + m * 16 + fr; const float s = tab[u.par * 256 + r];
                float* rowp = O + (size_t)(u.pm * BM + r) * ldc + col0;
#pragma unroll
                for (int bj = 0; bj < 2; ++bj) { *(f32x4*)(rowp + bj * HALF) = acc[ai][bj][m][0] * s; *(f32x4*)(rowp + bj * HALF + 4) = acc[ai][bj][m][1] * s; } }
    }
};

template <class Epi, class Sched, bool ALIGN_EPI = false, bool SP2 = false, bool FP8 = false>
__device__ __forceinline__ void gemm_phase(LAS unsigned char* lds, const Gemm g, const Sched& S, const Epi& E) {
    int tid = threadIdx.x; asm volatile("" : "+v"(tid));
    const int wid = __builtin_amdgcn_readfirstlane(tid >> 6), lane = tid & 63, wr = wid >> 2, wc = wid & 3, fr = lane & 15, fq = lane >> 4;
    int Kx = g.K; asm volatile("" : "+s"(Kx));
    const int nt = Kx / BK; const int K = g.Kp ? g.Kp : Kx;
    unsigned voffA[2], voffB[2];
#pragma unroll
    for (int i = 0; i < 2; ++i) { int R, C; stage_rc(tid * 16 + i * 8192, R, C); const int Rb = Epi::PERM ? ((R & ~31) + perm32(R & 31)) : R;
        voffA[i] = (unsigned)(R * K + C) * 2u; voffB[i] = (unsigned)(Rb * K + C) * 2u; }
    const size_t kstep = (size_t)(BK * 2);
    const size_t hstep = (size_t)HALF * K * 2;
    const size_t tstep = 2 * hstep;
    const unsigned ldsw = (unsigned)wid * 1024u;
    const int aoff = lds_byte(wr * 64 + fr, fq * 8), boff = lds_byte(wc * 32 + fr, fq * 8);
#define PG8_SA(b, h) (((b) * 2 + (h)) * HTB)
#define PG8_SB(b, h) ((4 + (b) * 2 + (h)) * HTB)
#define PG8_STAGE(bufoff, gbase, voff) do { _Pragma("unroll") for (int _i = 0; _i < 2; ++_i) \
        __builtin_amdgcn_global_load_lds((const unsigned*)((const char*)(gbase) + (voff)[_i]), (LAS unsigned*)(lds + (bufoff) + ldsw + _i * 8192), 16, 0, 0); } while (0)
#define PG8_LDA(dst, b, h) do { _Pragma("unroll") for (int m = 0; m < 4; ++m) _Pragma("unroll") for (int k = 0; k < 2; ++k) dst[m][k] = *(const LAS bf16x8*)(lds + PG8_SA(b, h) + aoff + m * 2048 + k * 1024); } while (0)
#define PG8_LDB(dst, b, h) do { _Pragma("unroll") for (int n = 0; n < 2; ++n) _Pragma("unroll") for (int k = 0; k < 2; ++k) dst[n][k] = *(const LAS bf16x8*)(lds + PG8_SB(b, h) + boff + n * 2048 + k * 1024); } while (0)
#define PG8_MMA(ai, bj, At, Bt) do { __builtin_amdgcn_s_setprio(1); _Pragma("unroll") for (int m = 0; m < 4; ++m) _Pragma("unroll") for (int n = 0; n < 2; ++n) { \
        if constexpr (FP8) mfma_f8(acc[ai][bj][m][n], cat16(Bt[n][0], Bt[n][1]), cat16(At[m][0], At[m][1])); \
        else { _Pragma("unroll") for (int k = 0; k < 2; ++k) acc[ai][bj][m][n] = __builtin_amdgcn_mfma_f32_16x16x32_bf16(Bt[n][k], At[m][k], acc[ai][bj][m][n], 0, 0, 0); } } \
        __builtin_amdgcn_s_setprio(0); } while (0)
#define PG8_WAIT_V(n) asm volatile("s_waitcnt vmcnt(" #n ")" ::: "memory")
#define PG8_WAIT_L(n) asm volatile("s_waitcnt lgkmcnt(" #n ")" ::: "memory")
#define PG8_BAR __builtin_amdgcn_s_barrier()
#define PG8_SCHED __builtin_amdgcn_sched_barrier(0)
    Unit cur, nxt; int ui = 0;
    if (!S.next(0, cur)) return;
    f32x4 acc[2][2][4][2];
#pragma unroll
    for (int a = 0; a < 2; ++a)
#pragma unroll
        for (int b = 0; b < 2; ++b)
#pragma unroll
            for (int m = 0; m < 4; ++m)
#pragma unroll
                for (int n = 0; n < 2; ++n) acc[a][b][m][n] = (f32x4){0.f, 0.f, 0.f, 0.f};
    bf16x8 At[4][2], B0[2][2], B1[2][2];
    const char* cA = (const char*)g.A + (size_t)cur.pm * tstep; const char* cB = (const char*)g.Bt + (size_t)cur.pn * tstep;
    S.a_ready(cur);
    if constexpr (SP2) {
        PG8_STAGE(PG8_SB(0, 0), cB, voffB); PG8_STAGE(PG8_SB(0, 1), cB + hstep, voffB); PG8_STAGE(PG8_SA(0, 0), cA, voffA); PG8_STAGE(PG8_SA(0, 1), cA + hstep, voffA);
        if (wr == 1) PG8_BAR;
        PG8_WAIT_V(2); PG8_BAR;
        PG8_STAGE(PG8_SB(1, 0), cB + kstep, voffB); PG8_STAGE(PG8_SA(1, 0), cA + kstep, voffA); PG8_STAGE(PG8_SB(1, 1), cB + hstep + kstep, voffB);
        PG8_WAIT_V(6); PG8_BAR;
    } else {
        PG8_STAGE(PG8_SB(0, 0), cB, voffB); PG8_STAGE(PG8_SA(0, 0), cA, voffA); PG8_STAGE(PG8_SB(0, 1), cB + hstep, voffB); PG8_STAGE(PG8_SA(0, 1), cA + hstep, voffA);
        if (wr == 1) PG8_BAR;
        PG8_WAIT_V(4); PG8_BAR;
        PG8_STAGE(PG8_SB(1, 0), cB + kstep, voffB); PG8_STAGE(PG8_SA(1, 0), cA + kstep, voffA); PG8_STAGE(PG8_SB(1, 1), cB + hstep + kstep, voffB);
        PG8_WAIT_V(6); PG8_BAR;
    }
    for (;;) {
        const bool has_next = S.next(ui + 1, nxt);
        const char* nA = has_next ? (const char*)g.A + (size_t)nxt.pm * tstep : cA; const char* nB = has_next ? (const char*)g.Bt + (size_t)nxt.pn * tstep : cB;
        for (int t = 0; t < nt; t += 2) {
            const bool last = (t == nt - 2);
            const char* a1 = cA + (size_t)(t + 1) * kstep;
            const char* a2 = last ? nA : cA + (size_t)(t + 2) * kstep; const char* b2 = last ? nB : cB + (size_t)(t + 2) * kstep;
            const char* a3 = a2 + kstep; const char* b3 = b2 + kstep;
            if (last && has_next) S.a_ready(nxt);
            if constexpr (SP2) {
            PG8_LDB(B0, 0, 0); PG8_LDB(B1, 0, 1); PG8_SCHED; PG8_LDA(At, 0, 0); PG8_STAGE(PG8_SA(1, 1), a1 + hstep, voffA);
            PG8_WAIT_V(8); PG8_WAIT_L(0); PG8_BAR; PG8_MMA(0, 0, At, B0); PG8_MMA(0, 1, At, B1); PG8_BAR; PG8_SCHED;
            PG8_LDA(At, 0, 1); PG8_STAGE(PG8_SB(0, 0), b2, voffB); PG8_STAGE(PG8_SB(0, 1), b2 + hstep, voffB); PG8_STAGE(PG8_SA(0, 0), a2, voffA);
            PG8_WAIT_V(8); PG8_WAIT_L(0); PG8_BAR; PG8_MMA(1, 0, At, B0); PG8_MMA(1, 1, At, B1); PG8_BAR; PG8_SCHED;
            PG8_LDB(B0, 1, 0); PG8_LDB(B1, 1, 1); PG8_SCHED; PG8_LDA(At, 1, 0); PG8_STAGE(PG8_SA(0, 1), a2 + hstep, voffA);
            PG8_WAIT_V(8); PG8_WAIT_L(0); PG8_BAR; PG8_MMA(0, 0, At, B0); PG8_MMA(0, 1, At, B1); PG8_BAR; PG8_SCHED;
            PG8_LDA(At, 1, 1); PG8_STAGE(PG8_SB(1, 0), b3, voffB); PG8_STAGE(PG8_SB(1, 1), b3 + hstep, voffB); PG8_STAGE(PG8_SA(1, 0), a3, voffA);
            PG8_WAIT_V(8); PG8_WAIT_L(0); PG8_BAR; PG8_MMA(1, 0, At, B0); PG8_MMA(1, 1, At, B1); PG8_BAR; PG8_SCHED;
            } else {
            PG8_LDB(B0, 0, 0); PG8_SCHED; PG8_LDA(At, 0, 0); PG8_STAGE(PG8_SA(1, 1), a1 + hstep, voffA);
            PG8_WAIT_L(8); PG8_BAR; PG8_WAIT_L(0); PG8_MMA(0, 0, At, B0); PG8_BAR; PG8_SCHED;
            PG8_LDB(B1, 0, 1); PG8_STAGE(PG8_SB(0, 0), b2, voffB);
            PG8_BAR; PG8_WAIT_L(0); PG8_MMA(0, 1, At, B1); PG8_BAR;
            PG8_LDA(At, 0, 1); PG8_STAGE(PG8_SA(0, 0), a2, voffA);
            PG8_BAR; PG8_WAIT_L(0); PG8_MMA(1, 0, At, B0); PG8_BAR; PG8_SCHED;
            PG8_STAGE(PG8_SB(0, 1), b2 + hstep, voffB);
            PG8_WAIT_V(6); PG8_BAR; PG8_MMA(1, 1, At, B1); PG8_BAR;
            PG8_LDB(B0, 1, 0); PG8_SCHED; PG8_LDA(At, 1, 0); PG8_STAGE(PG8_SA(0, 1), a2 + hstep, voffA);
            PG8_WAIT_L(8); PG8_BAR; PG8_WAIT_L(0); PG8_MMA(0, 0, At, B0); PG8_BAR; PG8_SCHED;
            PG8_LDB(B1, 1, 1); PG8_STAGE(PG8_SB(1, 0), b3, voffB);
            PG8_BAR; PG8_WAIT_L(0); PG8_MMA(0, 1, At, B1); PG8_BAR;
            PG8_LDA(At, 1, 1); PG8_STAGE(PG8_SA(1, 0), a3, voffA);
            PG8_BAR; PG8_WAIT_L(0); PG8_MMA(1, 0, At, B0); PG8_BAR; PG8_SCHED;
            PG8_STAGE(PG8_SB(1, 1), b3 + hstep, voffB);
            PG8_WAIT_V(6); PG8_BAR; PG8_MMA(1, 1, At, B1); PG8_BAR;
            }
        }
        if constexpr (ALIGN_EPI) { if (wr == 0) PG8_BAR; }
        if constexpr (FP8) { asm volatile("s_nop 15\n\ts_nop 15" ::: "memory"); PG8_SCHED; }
        if constexpr (!Epi::AFTER_DRAIN) { E(acc, cur, wr, wc, fr, fq); S.done(cur); }
        if (!has_next) break;
#pragma unroll
        for (int a = 0; a < 2; ++a)
#pragma unroll
            for (int b = 0; b < 2; ++b)
#pragma unroll
                for (int m = 0; m < 4; ++m)
#pragma unroll
                    for (int n = 0; n < 2; ++n) acc[a][b][m][n] = (f32x4){0.f, 0.f, 0.f, 0.f};
        cur = nxt; cA = nA; cB = nB; ++ui;
        if constexpr (ALIGN_EPI) { if (wr == 1) PG8_BAR; }
    }
    PG8_WAIT_V(0);
    if constexpr (!ALIGN_EPI) { if (wr == 0) PG8_BAR; }
    PG8_BAR;
#undef PG8_SA
#undef PG8_SB
#undef PG8_STAGE
#undef PG8_LDA
#undef PG8_LDB
#undef PG8_MMA
#undef PG8_WAIT_V
#undef PG8_WAIT_L
#undef PG8_BAR
#undef PG8_SCHED
}
}

namespace fox {
using bf16 = __hip_bfloat16;
typedef short bf16x8 __attribute__((ext_vector_type(8)));
typedef short s16x4 __attribute__((ext_vector_type(4)));
typedef float f32x16 __attribute__((ext_vector_type(16)));
typedef float f32x4 __attribute__((ext_vector_type(4)));
typedef unsigned u32x4 __attribute__((ext_vector_type(4)));
constexpr int D = 128, LD = DM, LDKV = 128;
constexpr float SCALE = 0.08838834764831845f;
constexpr float THR = 8.f;
constexpr int NW = 8, QBLK = 32, KVBLK = 64, QB = NW * QBLK;
constexpr int SHM_V = KVBLK * D * 2, SHM_K = KVBLK * D * 2;
constexpr int CB_OFF = 2 * SHM_V + 2 * SHM_K + NW * 64 * 4;
constexpr int QS_OFF = CB_OFF + 2 * SEQ * 4;
constexpr int WSUM_OFF = QS_OFF + NW * 8192;
constexpr int LDS_BYTES = WSUM_OFF + 64;

#define KSWZ(row, colB) ((row) * 256 + ((colB) ^ (((row) & 7) << 4)))
#define SBAR() __builtin_amdgcn_sched_barrier(0)
__device__ __forceinline__ int v_st(int k, int c) { const int kk = (k & ~0xC) | ((k & 4) << 1) | ((k & 8) >> 1); return ((kk >> 3) * 4 + (c >> 5)) * 512 + ((kk & 7) * 32 + (c & 31)) * 2; }
__device__ __forceinline__ int v_rd_base(int lane) { return ((lane & 3) << 3) | (((lane >> 2) & 3) << 6) | (((lane >> 4) & 1) << 5) | (((lane >> 5) & 1) << 8); }
constexpr int v_rd_off(int d0, int ks, int half) { return d0 * 512 + ks * 4096 + half * 2048; }
__device__ __forceinline__ int crow(int r, int hi) { return (r & 3) + 8 * (r >> 2) + 4 * hi; }
__device__ __forceinline__ unsigned cvtpk(float lo, float hi) { unsigned r; asm volatile("v_cvt_pk_bf16_f32 %0, %1, %2" : "=v"(r) : "v"(lo), "v"(hi)); return r; }
__device__ __forceinline__ bf16x8 load8(const bf16* p) { return *reinterpret_cast<const bf16x8*>(p); }
__device__ __forceinline__ void mask_tile(f32x16& p0, f32x16& p1, int dq) {
    const float NEG = -__builtin_inff();
#pragma unroll
    for (int r = 0; r < 16; ++r) {
        const int c = (r & 3) + 8 * (r >> 2);
        if (dq - c < 0) p0[r] = NEG;
        if (dq - c - 32 < 0) p1[r] = NEG;
    }
}
__device__ __forceinline__ void partialSM(f32x16& p0, f32x16& p1, float& m_reg, float& mn, float& alpha) {
    float pmax = p0[0]; for (int r = 1; r < 16; ++r) pmax = fmaxf(pmax, p0[r]); for (int r = 0; r < 16; ++r) pmax = fmaxf(pmax, p1[r]);
    { auto rr = __builtin_amdgcn_permlane32_swap(__float_as_uint(pmax), __float_as_uint(pmax), false, false);
      pmax = fmaxf(__uint_as_float(rr[0]), __uint_as_float(rr[1])); }
    constexpr float C2 = 1.4426950408889634f * SCALE;
    if (__builtin_expect(__all((pmax - m_reg) * SCALE <= THR), 1)) { mn = m_reg; alpha = 1.f; }
    else { mn = fmaxf(m_reg, pmax); alpha = __builtin_amdgcn_exp2f((m_reg - mn) * C2); m_reg = mn; }
    const float mnL = -mn * C2;
    for (int r = 0; r < 16; ++r) p0[r] = fmaf(p0[r], C2, mnL); for (int r = 0; r < 16; ++r) p1[r] = fmaf(p1[r], C2, mnL);
    for (int r = 0; r < 16; ++r) p0[r] = __builtin_amdgcn_exp2f(p0[r]);
}
__device__ __forceinline__ void finishSM(f32x16& p0, f32x16& p1, float alpha, float& l_reg, bf16x8& pa0, bf16x8& pa1, bf16x8& pa2, bf16x8& pa3) {
    for (int r = 0; r < 16; ++r) p1[r] = __builtin_amdgcn_exp2f(p1[r]);
    float ps = 0; for (int r = 0; r < 16; ++r) ps += p0[r]; for (int r = 0; r < 16; ++r) ps += p1[r];
    { auto rr = __builtin_amdgcn_permlane32_swap(__float_as_uint(ps), __float_as_uint(ps), false, false);
      ps = __uint_as_float(rr[0]) + __uint_as_float(rr[1]); }
    l_reg = l_reg * alpha + ps;
#define PK4(P, B_, OUT) do { unsigned a0 = cvtpk(P[B_+0], P[B_+1]), a1 = cvtpk(P[B_+2], P[B_+3]);                          \
        unsigned b0 = cvtpk(P[B_+4], P[B_+5]), b1 = cvtpk(P[B_+6], P[B_+7]);                                             \
        auto r0 = __builtin_amdgcn_permlane32_swap(a0, b0, false, false); auto r1 = __builtin_amdgcn_permlane32_swap(a1, b1, false, false); \
        u32x4 w = {r0[0], r1[0], r0[1], r1[1]}; OUT = *reinterpret_cast<bf16x8*>(&w); } while (0)
    PK4(p0, 0, pa0); PK4(p0, 8, pa1); PK4(p1, 0, pa2); PK4(p1, 8, pa3);
#undef PK4
}
#ifndef QREG
#define QREG 4
#endif
template <int KB>
__device__ __forceinline__ void qkt(f32x16& p0, f32x16& p1, const char* K_lds, int r32, int hi, const char* qs, const bf16x8* qr, const float* cbt) {
    { const f32x4 a0 = *(const f32x4*)(cbt), a1 = *(const f32x4*)(cbt + 8), a2 = *(const f32x4*)(cbt + 16), a3 = *(const f32x4*)(cbt + 24);
      const f32x4 b0 = *(const f32x4*)(cbt + 32), b1 = *(const f32x4*)(cbt + 40), b2 = *(const f32x4*)(cbt + 48), b3 = *(const f32x4*)(cbt + 56);
      p0 = (f32x16){a0[0], a0[1], a0[2], a0[3], a1[0], a1[1], a1[2], a1[3], a2[0], a2[1], a2[2], a2[3], a3[0], a3[1], a3[2], a3[3]};
      p1 = (f32x16){b0[0], b0[1], b0[2], b0[3], b1[0], b1[1], b1[2], b1[3], b2[0], b2[1], b2[2], b2[3], b3[0], b3[1], b3[2], b3[3]}; }
    const char* kb[4];
#pragma unroll
    for (int dd = 0; dd < 4; ++dd) kb[dd] = K_lds + KB * SHM_K + KSWZ(r32, (dd * 16 + hi * 8) * 2);
#pragma unroll
    for (int d0 = 0; d0 < 8; ++d0) { const char* a = kb[d0 & 3] + (d0 >> 2) * 128;
        bf16x8 b0 = *reinterpret_cast<const bf16x8*>(a);
        bf16x8 b1 = *reinterpret_cast<const bf16x8*>(a + 32 * 256);
        const bf16x8 q = (d0 < QREG) ? qr[d0] : *reinterpret_cast<const bf16x8*>(qs + d0 * 1024);
        p0 = __builtin_amdgcn_mfma_f32_32x32x16_bf16(b0, q, p0, 0, 0, 0);
        p1 = __builtin_amdgcn_mfma_f32_32x32x16_bf16(b1, q, p1, 0, 0, 0); }
}
template <int VB>
__device__ __forceinline__ void pv_tile(f32x16* o, int vb0, bf16x8 pa0, bf16x8 pa1, bf16x8 pa2, bf16x8 pa3) {
#define TRRD(dst, off) asm volatile("ds_read_b64_tr_b16 %0, %1 offset:%2" : "=&v"(dst) : "v"(vb0), "i"(off) : "memory")
#define PV_D0(d0) do { s16x4 l0, l1, l2, l3, h0, h1, h2, h3; constexpr int b_ = VB * SHM_V + v_rd_off(d0, 0, 0); \
        TRRD(l0, b_); TRRD(h0, b_ + 2048); TRRD(l1, b_ + 4096); TRRD(h1, b_ + 6144); TRRD(l2, b_ + 8192); TRRD(h2, b_ + 10240); TRRD(l3, b_ + 12288); TRRD(h3, b_ + 14336); \
        asm volatile("s_waitcnt lgkmcnt(0)" ::: "memory"); SBAR();   \
        o[d0] = __builtin_amdgcn_mfma_f32_32x32x16_bf16(pa0, (bf16x8){l0[0], l0[1], l0[2], l0[3], h0[0], h0[1], h0[2], h0[3]}, o[d0], 0, 0, 0);   \
        o[d0] = __builtin_amdgcn_mfma_f32_32x32x16_bf16(pa1, (bf16x8){l1[0], l1[1], l1[2], l1[3], h1[0], h1[1], h1[2], h1[3]}, o[d0], 0, 0, 0);   \
        o[d0] = __builtin_amdgcn_mfma_f32_32x32x16_bf16(pa2, (bf16x8){l2[0], l2[1], l2[2], l2[3], h2[0], h2[1], h2[2], h2[3]}, o[d0], 0, 0, 0);   \
        o[d0] = __builtin_amdgcn_mfma_f32_32x32x16_bf16(pa3, (bf16x8){l3[0], l3[1], l3[2], l3[3], h3[0], h3[1], h3[2], h3[3]}, o[d0], 0, 0, 0); } while (0)
    PV_D0(0); PV_D0(1); PV_D0(2); PV_D0(3);
#undef PV_D0
#undef TRRD
}
struct Ptrs { const bf16* Q; const bf16* K; const bf16* V; bf16* O; const float* CB; };
struct BlockRef { unsigned qoff, kvoff, cboff; int P0; };
struct Seam { bf16x8 qr[8]; bf16x8 st_v0, st_v1, st_k0, st_k1; };
#define ROW(p, k0, rr) ((p) + (size_t)((k0) + (rr)) * LDKV + sc)
#define VMW() asm volatile("s_waitcnt vmcnt(0)" ::: "memory")
#define VMWN(n) asm volatile("s_waitcnt vmcnt(%0)" :: "i"(n) : "memory")
#define SLOAD_H(Kp, Vp, k0) do { S.st_v0 = load8(ROW(Vp, k0, sr)); S.st_v1 = load8(ROW(Vp, k0, 32 + sr));              \
                         S.st_k0 = load8(ROW(Kp, k0, sr)); S.st_k1 = load8(ROW(Kp, k0, 32 + sr)); } while (0)
#define SWRITE_HK(bf) do { *(bf16x8*)(K_lds + (bf) * SHM_K + kws) = S.st_k0; *(bf16x8*)(K_lds + (bf) * SHM_K + kws + 32 * 256) = S.st_k1; } while (0)
#define SWRITE_HV(bf) do { *(bf16x8*)(V_lds + (bf) * SHM_V + vst0) = S.st_v0; *(bf16x8*)(V_lds + (bf) * SHM_V + vst1) = S.st_v1; } while (0)
#define SWRITE_H(bf) do { SWRITE_HV(bf); SWRITE_HK(bf); } while (0)
__device__ __forceinline__ void load_cb(const Ptrs& P, const BlockRef& b, char* lds, int par) {
    const int tid = threadIdx.x, lane = tid & 63, wid = tid >> 6; float* dst = (float*)(lds + CB_OFF + par * (SEQ * 4)); float* wsum = (float*)(lds + WSUM_OFF);
    const f32x4 v = *(const f32x4*)(P.CB + b.cboff + 4 * tid);
    const float a0 = v[0], a1 = a0 + v[1], a2 = a1 + v[2], a3 = a2 + v[3];
    float incl = a3;
#pragma unroll
    for (int o = 1; o < 64; o <<= 1) { const float t = __shfl_up(incl, o); if (lane >= o) incl += t; }
    if (lane == 63) wsum[wid] = incl;
    __syncthreads();
    float off = incl - a3;
#pragma unroll
    for (int w = 0; w < NW; ++w) off += (w < wid) ? wsum[w] : 0.f;
    const float k = -11.313708498984761f;
    *(f32x4*)(dst + 4 * tid) = (f32x4){(off + a0) * k, (off + a1) * k, (off + a2) * k, (off + a3) * k};
}
__device__ __forceinline__ void fox_prime(const Ptrs& P, const BlockRef& cur, char* lds, Seam& S) {
    const int tid = threadIdx.x, wid = __builtin_amdgcn_readfirstlane(tid >> 6), lane = tid & 63, r32 = lane & 31, hi = lane >> 5;
    const int sr = tid >> 4, sc = (tid & 15) * 8, kws = KSWZ(sr, sc * 2); char* K_lds = lds + 2 * SHM_V;
    for (int d0 = 0; d0 < 8; ++d0) S.qr[d0] = load8(P.Q + cur.qoff + (size_t)(wid * QBLK + r32) * LD + d0 * 16 + hi * 8);
    SLOAD_H(P.K + cur.kvoff, P.V + cur.kvoff, 0); VMW(); SWRITE_HK(0);
    load_cb(P, cur, lds, 0);
    __syncthreads();
}
__device__ __forceinline__ void fox_block(const Ptrs& P, const BlockRef& cur, const BlockRef& nxt, int par, char* lds, Seam& S) {
    const int tid = threadIdx.x, wid = __builtin_amdgcn_readfirstlane(tid >> 6), lane = tid & 63, r32 = lane & 31, hi = lane >> 5;
    const int NT = (cur.P0 + QB) / KVBLK;
    const int qlo = cur.P0 + wid * QBLK, qm = qlo + r32 - 4 * hi;
    char* V_lds = lds; char* K_lds = lds + 2 * SHM_V;
    float* ws = (float*)(lds + 2 * SHM_V + 2 * SHM_K) + wid * 64; float* li_l = ws, * al_l = ws + 32;
    const float* cbl = (const float*)(lds + CB_OFF + par * (SEQ * 4)) + 4 * hi;
    float m_reg = -1e30f, l_reg = 0; f32x16 o[4] = {};
    const int sr = tid >> 4, sc = (tid & 15) * 8, vst0 = v_st(sr, sc), vst1 = v_st(32 + sr, sc), kws = KSWZ(sr, sc * 2);
    const int vb0 = (int)(uintptr_t)V_lds + v_rd_base(lane);
    const bf16* Kh = P.K + cur.kvoff; const bf16* Vh = P.V + cur.kvoff;
    char* qs = lds + QS_OFF + wid * 8192 + lane * 16;
#define RESC(a) do { if (__any((a) < 1.f)) { if (hi == 0) al_l[r32] = (a); asm volatile("s_waitcnt lgkmcnt(0)" ::: "memory");              \
                     for (int d_ = 0; d_ < 4; ++d_) for (int r = 0; r < 16; ++r) o[d_][r] *= al_l[crow(r, hi)]; } } while (0)
#define KBASE(t) ((t) * KVBLK)
#define MASKT(P0_, P1_, t) do { const int kb_ = KBASE(t); if (kb_ + KVBLK - 1 > qlo) mask_tile(P0_, P1_, qm - kb_); } while (0)
    constexpr int NQL = 8;
#define SEAM_K0() do { VMWN(NQL); SWRITE_HK(0); SBAR(); } while (0)
    f32x16 pA0, pA1, pB0, pB1; float mnA, mnB, alA, alB; bf16x8 pa0, pa1, pa2, pa3;
    SWRITE_HV(0);
#pragma unroll
    for (int d0 = QREG; d0 < 8; ++d0) *(bf16x8*)(qs + d0 * 1024) = S.qr[d0];
    SBAR();
    if (NT > 1) { SLOAD_H(Kh, Vh, KBASE(1)); }
    SBAR(); qkt<0>(pA0, pA1, K_lds, r32, hi, qs, S.qr, cbl);
    MASKT(pA0, pA1, 0); partialSM(pA0, pA1, m_reg, mnA, alA);
    if (NT > 1) { VMW(); SWRITE_H(1); }
    __syncthreads();
#define HALF_STEP(PX0, PX1, mnX, alX, PY0, PY1, alY, t, KB, VB, SB) do {                                                      \
        SBAR(); qkt<KB>(PX0, PX1, K_lds, r32, hi, qs, S.qr, cbl + (t) * KVBLK);                                                   \
        finishSM(PY0, PY1, alY, l_reg, pa0, pa1, pa2, pa3); SBAR();                                                           \
        if ((t) + 1 < NT) { SLOAD_H(Kh, Vh, KBASE((t) + 1)); SBAR(); }                                                        \
        pv_tile<VB>(o, vb0, pa0, pa1, pa2, pa3); MASKT(PX0, PX1, (t)); partialSM(PX0, PX1, m_reg, mnX, alX);                  \
        __syncthreads();                                                                                                      \
        if ((t) + 1 < NT) { VMW(); SWRITE_H(SB); }                                                                            \
        RESC(alX); __syncthreads(); } while (0)
    for (int t = 1; t + 1 < NT; t += 2) {
        HALF_STEP(pB0, pB1, mnB, alB, pA0, pA1, alA, t, 1, 0, 0);
        HALF_STEP(pA0, pA1, mnA, alA, pB0, pB1, alB, t + 1, 0, 1, 1);
    }
    const bool even = (NT & 1) == 0;
    if (even) { SBAR(); qkt<1>(pB0, pB1, K_lds, r32, hi, qs, S.qr, cbl + (NT - 1) * KVBLK); SBAR(); }
    SLOAD_H(P.K + nxt.kvoff, P.V + nxt.kvoff, 0); SBAR();
#pragma unroll
    for (int d0 = 0; d0 < 8; ++d0) S.qr[d0] = load8(P.Q + nxt.qoff + (size_t)(wid * QBLK + r32) * LD + d0 * 16 + hi * 8);
    SBAR();
    finishSM(pA0, pA1, alA, l_reg, pa0, pa1, pa2, pa3); SBAR();
    pv_tile<0>(o, vb0, pa0, pa1, pa2, pa3);
    if (even) { MASKT(pB0, pB1, NT - 1); partialSM(pB0, pB1, m_reg, mnB, alB); __syncthreads(); RESC(alB);
        finishSM(pB0, pB1, alB, l_reg, pa0, pa1, pa2, pa3); SBAR(); pv_tile<1>(o, vb0, pa0, pa1, pa2, pa3); }
    SBAR(); SEAM_K0();
    if (hi == 0) li_l[r32] = l_reg; asm volatile("s_waitcnt lgkmcnt(0)" ::: "memory");
    float rli[16];
#pragma unroll
    for (int r = 0; r < 16; ++r) rli[r] = __builtin_amdgcn_rcpf(li_l[crow(r, hi)]);
    bf16* Ow = P.O + cur.qoff + (size_t)(wid * QBLK) * LD;
    if (FP8_WO) {
        unsigned char* stg = (unsigned char*)(lds + QS_OFF + wid * 8192);
#pragma unroll
        for (int r = 0; r < 16; ++r) { const int orow = crow(r, hi);
#pragma unroll
            for (int d0 = 0; d0 < 4; ++d0) { float v = o[d0][r] * rli[r] * 16.0f; v = __builtin_amdgcn_fmed3f(v, -448.0f, 448.0f);
                stg[orow * 128 + d0 * 32 + r32] = (unsigned char)(__builtin_amdgcn_cvt_pk_fp8_f32(v, v, 0, false) & 0xff); } }
        asm volatile("s_waitcnt lgkmcnt(0)" ::: "memory");
        int ln = lane; asm volatile("" : "+v"(ln));
        unsigned char* Ob = (unsigned char*)P.O + cur.qoff + (size_t)(wid * QBLK) * LD;
#pragma unroll
        for (int i = 0; i < 4; ++i) { const int row = i * 8 + (ln >> 3), ch = ln & 7;
            const u32x4 v = *(const u32x4*)(stg + row * 128 + ch * 16); *(u32x4*)(Ob + (size_t)row * LD + ch * 16) = v; }
        asm volatile("s_waitcnt lgkmcnt(0)" ::: "memory");
    } else {
        unsigned short* stg = (unsigned short*)(lds + QS_OFF + wid * 8192);
#pragma unroll
        for (int r = 0; r < 16; ++r) { const int orow = crow(r, hi);
#pragma unroll
            for (int d0 = 0; d0 < 4; ++d0) stg[orow * 128 + d0 * 32 + r32] = (unsigned short)(cvtpk(o[d0][r] * rli[r], 0.f) & 0xffffu); }
        asm volatile("s_waitcnt lgkmcnt(0)" ::: "memory");
        int ln = lane; asm volatile("" : "+v"(ln));
#pragma unroll
        for (int i = 0; i < 8; ++i) { const int row = i * 4 + (ln >> 4), ch = ln & 15;
            const u32x4 v = *(const u32x4*)(stg + row * 128 + ch * 8); *(u32x4*)(Ow + (size_t)row * LD + ch * 8) = v; if (i & 1) asm volatile("" ::: "memory"); }
        asm volatile("s_waitcnt lgkmcnt(0)" ::: "memory");
    }
    SBAR(); asm volatile("" ::: "memory");
    load_cb(P, nxt, lds, par ^ 1);
    __syncthreads();
#undef RESC
#undef KBASE
#undef MASKT
#undef SEAM_K0
#undef HALF_STEP
}
__device__ __forceinline__ BlockRef mk_ref(int L_, int pass) {
    const int bh = L_ >> 2, x = L_ & 3, qb = pass ? 7 - x : x, b = bh / NH, hh = bh - b * NH;
    BlockRef r; r.qoff = (unsigned)((b * SEQ + qb * QB) * DM + hh * HD); r.kvoff = (unsigned)(bh * SEQ * HD); r.cboff = (unsigned)(bh * SEQ); r.P0 = qb * QB; return r; }
#undef ROW
#undef VMW
#undef VMWN
#undef SLOAD_H
#undef SWRITE_HK
#undef SWRITE_HV
#undef SWRITE_H
#undef KSWZ
#undef SBAR
}

constexpr int NWAVES = 8;
typedef unsigned short bf16;
typedef unsigned v4u __attribute__((ext_vector_type(4)));
typedef float f32x4 __attribute__((ext_vector_type(4)));
typedef GAS unsigned gu32;
#define RLX_AGENT __ATOMIC_RELAXED, __HIP_MEMORY_SCOPE_AGENT
#define LDS_WAIT() asm volatile("s_waitcnt lgkmcnt(0)" ::: "memory")
#define VM_WAIT() asm volatile("s_waitcnt vmcnt(0)" ::: "memory")
__device__ __forceinline__ unsigned f2bf(float f) { unsigned u = __builtin_bit_cast(unsigned, f); return (u + 0x7fffu + ((u >> 16) & 1u)) >> 16; }
__device__ __forceinline__ unsigned pk2(float lo, float hi) { return f2bf(lo) | (f2bf(hi) << 16); }

constexpr size_t MiB = 1u << 20;
constexpr size_t al1(size_t x) { return (x + MiB - 1) / MiB * MiB; }
constexpr size_t WS_CTL = 0, CTL_ZERO_BYTES = 64 * 1024;
constexpr size_t SZ_TD = (size_t)T * DM * 2;
constexpr size_t WS_WCI = 1 * MiB;
constexpr size_t WS_WCO = WS_WCI + al1((size_t)3 * DM * DM * 2);
constexpr size_t WS_WGU = WS_WCO + al1((size_t)DM * DM * 2);
constexpr size_t WS_WFD = WS_WGU + al1((size_t)2 * DFF * DM * 2);
constexpr size_t WS_WPG = WS_WFD + al1((size_t)DM * DFF * 2);
constexpr size_t WS_WPU = WS_WPG + al1((size_t)2 * DM * DM * 2);
constexpr size_t WS_WQKV = WS_WPU + al1((size_t)2 * DM * PLE * 2);
constexpr size_t WS_WO = WS_WQKV + al1((size_t)3 * DM * DM * 2);
constexpr size_t WS_WMGU = WS_WO + al1((size_t)DM * DM * 2);
constexpr size_t WS_WMD = WS_WMGU + al1((size_t)NE * 2 * DFE * DM * 2);
constexpr size_t WS_WF = WS_WMD + al1((size_t)NE * DM * DFE * 2);
constexpr size_t WS_WR = WS_WF + al1((size_t)NH * DM * 4);
constexpr size_t WS_HB = WS_WR + al1((size_t)DM * NE * 4);
constexpr size_t WS_HB2 = WS_HB + al1(SZ_TD);
constexpr size_t WS_H8 = WS_HB2 + al1(SZ_TD);
constexpr size_t WS_H8B = WS_H8 + al1(SZ_TD / 2);
constexpr size_t WS_PB = WS_H8B + al1(SZ_TD / 2);
constexpr size_t WS_E0 = WS_PB + al1((size_t)2 * T * PLE * 2);
constexpr size_t WS_E1 = WS_E0 + SZ_TD;
constexpr size_t WS_U = WS_E1 + al1(SZ_TD);
constexpr size_t WS_BG = WS_U + al1(SZ_TD);
constexpr size_t WS_YB = WS_BG + al1(SZ_TD);
constexpr size_t WS_ACT = WS_YB + al1(SZ_TD);
constexpr size_t WS_Q = WS_ACT + al1((size_t)T * DFF * 2);
constexpr size_t WS_K = WS_Q + al1(SZ_TD);
constexpr size_t WS_V = WS_K + al1(SZ_TD);
constexpr size_t WS_O = WS_V + al1(SZ_TD);
constexpr size_t WS_LF = WS_O + al1(SZ_TD);
constexpr size_t WS_CB = WS_LF + al1((size_t)T * NH * 4);
constexpr size_t WS_SL1 = WS_CB + al1((size_t)T * NH * 4);
constexpr size_t WS_SL2 = WS_SL1 + al1((size_t)T * 32 * 4);
constexpr size_t WS_SL3 = WS_SL2 + al1((size_t)T * 32 * 4);
constexpr size_t WS_RSTD = WS_SL3 + al1((size_t)T * 32 * 4);
constexpr size_t WS_ROUTE = WS_RSTD + al1((size_t)3 * T * 4);
constexpr size_t WS_XG = WS_ROUTE + 1 * MiB;
constexpr size_t WS_RG = WS_XG + al1((size_t)MAXROWS * DM * 2);
constexpr size_t WS_ACTM = WS_RG + 1 * MiB;
constexpr size_t WS_YM = WS_ACTM + al1((size_t)MAXROWS * DFE * 2);
constexpr size_t WS_YP = WS_YM + al1((size_t)MAXROWS * DM * 4);
constexpr size_t WS_END = WS_YP + (size_t)256 * 65536 * 2;
constexpr int CW_SPLIT = 8192;
constexpr int CW_BAR = 1024;

constexpr int RING_OFF = 0, RING_BYTES = 131072;
constexpr int TAB_OFF = RING_BYTES;
constexpr int LDS_BYTES = 163840;
constexpr int MISC_OFF = LDS_BYTES - 512;
static_assert(TAB_OFF + 2048 + 8192 <= MISC_OFF, "LDS map (row-scale tables + the QKV epilogue's [256][8] reduction scratch)");
static_assert(fox::LDS_BYTES <= MISC_OFF, "attention LDS (overlays the row-scale tables, which are idle in that phase)");

#define XB_TMO      128
#define XB_XCNT(j)  (256  + 64 * (j))
#define XB_XSUB(j)  (1280 + 64 * (j))
#define XB_XGEN(j)  (2304 + 64 * (j))
#define XB_TOP      3328
#define XB_TOPGEN   3392
#define XCD_BAR_WORDS 3456
#define XB_SPIN_CAP (1u << 22)
__device__ __forceinline__ unsigned xb_ld(unsigned* p)              { return __hip_atomic_load(p, __ATOMIC_RELAXED, __HIP_MEMORY_SCOPE_AGENT); }
__device__ __forceinline__ unsigned xb_add(unsigned* p, unsigned v) { return __hip_atomic_fetch_add(p, v, __ATOMIC_RELAXED, __HIP_MEMORY_SCOPE_AGENT); }
__device__ __forceinline__ unsigned xb_xcc_id() { return (unsigned)__builtin_amdgcn_s_getreg((3 << 11) | 20) & 0xFu; }
#define XB_SPIN(cond, bar) do { unsigned _sp = 0; while (cond) { __builtin_amdgcn_s_sleep(1); \
    if ((++_sp & 255u) == 0u) { if (xb_ld(&(bar)[XB_TMO])) break; if (_sp > XB_SPIN_CAP) { atomicAdd(&(bar)[XB_TMO], 1u); break; } } } } while (0)
struct XcdBarrier { unsigned* bar; unsigned x; volatile LAS unsigned* st; };
__device__ __forceinline__ XcdBarrier xcd_barrier_post(unsigned* bar, volatile LAS unsigned* st) {
    XcdBarrier b; b.bar = bar; b.x = xb_xcc_id(); b.st = st;
    if (threadIdx.x == 0) st[3] = xb_add(&bar[XB_XCNT(b.x)], 1u);
    return b;
}
__device__ __forceinline__ void xcd_barrier_complete(unsigned* bar, unsigned x, unsigned& nloc, unsigned& nx, unsigned& uni) {
    const unsigned G = gridDim.x * gridDim.y * gridDim.z;
    unsigned sum, cnt, mine, sp = 0u;
    for (;;) {
        sum = 0u; cnt = 0u; mine = 0u;
#pragma unroll
        for (unsigned j = 0; j < 16; ++j) { const unsigned c = xb_ld(&bar[XB_XCNT(j)]); sum += c; cnt += (c > 0u) ? 1u : 0u; mine = (j == x) ? c : mine; }
        if (sum == G) break;
        __builtin_amdgcn_s_sleep(1);
        if ((++sp & 255u) == 0u) { if (xb_ld(&bar[XB_TMO])) break; if (sp > XB_SPIN_CAP) { atomicAdd(&bar[XB_TMO], 1u); break; } }
    }
    nloc = mine > 0u ? mine : 1u; nx = cnt > 0u ? cnt : 1u;
    uni = (sum == G && cnt == 8u && G % 8u == 0u) ? 1u : 0u;
#pragma unroll
    for (unsigned j = 0; j < 16; ++j) { const unsigned c = xb_ld(&bar[XB_XCNT(j)]); if (j < 8u ? c != G / 8u : c != 0u) uni = 0u; }
}
#ifndef EARLY_INV
#define EARLY_INV 1
#endif
__device__ __forceinline__ void xcd_barrier(const XcdBarrier& b, bool local = false) {
    asm volatile("s_waitcnt vmcnt(0)" ::: "memory");
    __syncthreads();
    if (threadIdx.x == 0) {
        unsigned* bar = b.bar;
        __builtin_amdgcn_s_waitcnt(0);
        unsigned nloc = b.st[0], nx = b.st[1];
        if (nloc == 0u) { unsigned uni; xcd_barrier_complete(bar, b.x, nloc, nx, uni); b.st[0] = nloc; b.st[1] = nx; b.st[2] = uni; }
        const bool loc = local && b.st[2] != 0u;
        if (EARLY_INV) asm volatile("buffer_inv sc1" ::: "memory");
        const unsigned old = xb_add(&bar[XB_XSUB(b.x)], 1u);
        const unsigned gen = old / nloc;
        if (loc) {
            const unsigned tgt = (gen + 1u) * nloc;
            XB_SPIN(xb_ld(&bar[XB_XSUB(b.x)]) < tgt, bar);
        } else {
            const unsigned gg = b.st[4]; b.st[4] = gg + 1u;
            if (old + 1u == (gen + 1u) * nloc) {
                __builtin_amdgcn_fence(__ATOMIC_RELEASE, "agent");
                asm volatile("s_waitcnt vmcnt(0)" ::: "memory");
                const unsigned og = xb_add(&bar[XB_TOP], 1u);
                const unsigned tg = og / nx;
                if (og + 1u == (tg + 1u) * nx) xb_add(&bar[XB_TOPGEN], 1u);
                else XB_SPIN(xb_ld(&bar[XB_TOPGEN]) == tg, bar);
                xb_add(&bar[XB_XGEN(b.x)], 1u);
            } else {
                XB_SPIN(xb_ld(&bar[XB_XGEN(b.x)]) == gg, bar);
            }
        }
        if (EARLY_INV) asm volatile("s_waitcnt vmcnt(0)" ::: "memory");
        else { __builtin_amdgcn_fence(__ATOMIC_ACQUIRE, "agent"); asm volatile("s_waitcnt vmcnt(0)" ::: "memory"); }
    }
    __syncthreads();
}

struct Frame {
    LAS unsigned char* lds;
    volatile LAS unsigned* MISC;
    LAS float* tab;
    gu32* ctl;
    int tid, lane, wave;
    int vcu, G;
    float* out; unsigned char* ws;
};
__device__ __forceinline__ const float* arg_in(int i) {
    const __attribute__((address_space(4))) char* ka = (const __attribute__((address_space(4))) char*)__builtin_amdgcn_kernarg_segment_ptr();
    asm volatile("" : "+s"(ka));
    return *(const float* const __attribute__((address_space(4)))*)(ka + 8 * i);
}

__device__ __forceinline__ float wave_sum(float v) {
#pragma unroll
    for (int o = 1; o < 64; o <<= 1) v += __shfl_xor(v, o);
    return v;
}

template <int W, int CNT> __device__ __forceinline__ void reduce_step(float (&v)[32], int lane) {
    const bool up = (lane & W) != 0;
#pragma unroll
    for (int k = 0; k < CNT; ++k) { const float send = up ? v[k] : v[k + CNT], keep = up ? v[k + CNT] : v[k]; v[k] = keep + __shfl_xor(send, W); }
}
__device__ __forceinline__ float reduce32(float (&v)[32], int lane) {
    reduce_step<32, 16>(v, lane); reduce_step<16, 8>(v, lane); reduce_step<8, 4>(v, lane); reduce_step<4, 2>(v, lane); reduce_step<2, 1>(v, lane);
    return v[0] + __shfl_xor(v[0], 1);
}
struct CvtJob { const float* W; int ld; int Kg; int groups; int N; const float* gain; int map; int F; bf16* dst; };
__device__ __forceinline__ int cvt_items(const CvtJob& j) { return j.groups * (j.Kg / 64) * (j.N / 32); }
__device__ __forceinline__ int map_col(int map, int F, int n0) {
    if (map == 1) { if (n0 < DM) return 2 * DM + n0; const int c = (n0 - DM) & (DM - 1), isx = (n0 >= 2 * DM); return 256 * (c >> 7) + (isx ? 128 : 0) + (c & 127); }
    if (map == 2) { const int isu = n0 >= F, c = isu ? n0 - F : n0; return 256 * (c >> 7) + (isu ? 128 : 0) + (c & 127); }
    return n0;
}
__device__ __forceinline__ void cvt_item(const CvtJob& j, LAS float* scr, int item, int lane) {
    const int nblk = j.N / 32, kpg = j.Kg / 64; const int kb = item / nblk, nb = item - kb * nblk, grp = kb / kpg, kl = kb - grp * kpg, k0 = 64 * kl, n0 = 32 * nb;
    const float* Wg = j.W + (size_t)grp * j.Kg * j.ld; const float* gn = j.gain ? j.gain + (size_t)grp * j.Kg : nullptr;
    float v[32];
    const float* src = Wg + (size_t)(k0 + (lane >> 5)) * j.ld + n0 + (lane & 31);
#pragma unroll
    for (int i = 0; i < 32; ++i) v[i] = src[(size_t)(2 * i) * j.ld];
    if (gn) {
#pragma unroll
        for (int i = 0; i < 32; ++i) v[i] *= gn[k0 + 2 * i + (lane >> 5)]; }
#pragma unroll
    for (int i = 0; i < 32; ++i) scr[(2 * i + (lane >> 5)) * 33 + (lane & 31)] = v[i];
    LDS_WAIT(); asm volatile("" ::: "memory");
    const int c = lane & 7; const int d0 = map_col(j.map, j.F, n0);
    bf16* D = j.dst + (size_t)grp * j.N * j.Kg;
#pragma unroll
    for (int q = 0; q < 4; ++q) { const int n = (lane >> 3) + 8 * q; const LAS float* s = scr + (8 * c) * 33 + n;
        v4u o; o.x = pk2(s[0 * 33], s[1 * 33]); o.y = pk2(s[2 * 33], s[3 * 33]); o.z = pk2(s[4 * 33], s[5 * 33]); o.w = pk2(s[6 * 33], s[7 * 33]);
        *(GAS v4u*)(D + (size_t)(d0 + n) * j.Kg + k0 + 8 * c) = o; }
    LDS_WAIT(); asm volatile("" ::: "memory");
}
__device__ __forceinline__ void cvt8_load(const CvtJob& j, int item, int lane, float (&v)[64]) {
    const int nblk = j.N / 32, kpg = j.Kg / 128; const int kb = item / nblk, nb = item - kb * nblk, grp = kb / kpg, kl = kb - grp * kpg, k0 = 128 * kl, n0 = 32 * nb;
    const float* src = j.W + (size_t)grp * j.Kg * j.ld + (size_t)(k0 + (lane >> 5)) * j.ld + n0 + (lane & 31);
#pragma unroll
    for (int i = 0; i < 64; ++i) v[i] = __builtin_nontemporal_load(src + (size_t)(2 * i) * j.ld);
}
__device__ __forceinline__ void cvt8_finish(const CvtJob& j, float wscale, const LAS float* gtab, LAS float* scr, int item, int lane, const float (&v)[64]) {
    const int nblk = j.N / 32, kpg = j.Kg / 128; const int kb = item / nblk, nb = item - kb * nblk, grp = kb / kpg, kl = kb - grp * kpg, k0 = 128 * kl, n0 = 32 * nb;
#pragma unroll
    for (int i = 0; i < 64; ++i) scr[(2 * i + (lane >> 5)) * 33 + (lane & 31)] = v[i] * wscale;
    LDS_WAIT(); asm volatile("" ::: "memory");
    const int c = lane & 7; const int d0 = map_col(j.map, j.F, n0);
    unsigned char* D = (unsigned char*)j.dst + (size_t)grp * j.N * j.Kg;
    float g[16];
#pragma unroll
    for (int i = 0; i < 16; ++i) g[i] = gtab ? gtab[k0 + 16 * c + i] : 1.0f;
#pragma unroll
    for (int q = 0; q < 4; ++q) { const int n = (lane >> 3) + 8 * q; const LAS float* s = scr + (16 * c) * 33 + n;
        v4u o; o.x = pg8::pk4_fp8(s[0 * 33] * g[0], s[1 * 33] * g[1], s[2 * 33] * g[2], s[3 * 33] * g[3]); o.y = pg8::pk4_fp8(s[4 * 33] * g[4], s[5 * 33] * g[5], s[6 * 33] * g[6], s[7 * 33] * g[7]);
        o.z = pg8::pk4_fp8(s[8 * 33] * g[8], s[9 * 33] * g[9], s[10 * 33] * g[10], s[11 * 33] * g[11]); o.w = pg8::pk4_fp8(s[12 * 33] * g[12], s[13 * 33] * g[13], s[14 * 33] * g[14], s[15 * 33] * g[15]);
        __builtin_nontemporal_store(o, (GAS v4u*)(D + (size_t)(d0 + n) * j.Kg + k0 + 16 * c)); }
    LDS_WAIT(); asm volatile("" ::: "memory");
}
__device__ __forceinline__ void cvt_item8(const CvtJob& j, float wscale, LAS float* scr, int item, int lane) {
    float v[64]; cvt8_load(j, item, lane, v);
    if (j.gain) { const int nblk = j.N / 32, kpg = j.Kg / 128; const int kb = item / nblk, kl = kb % kpg, k0 = 128 * kl;
#pragma unroll
        for (int i = 0; i < 64; ++i) v[i] *= j.gain[k0 + 2 * i + (lane >> 5)]; }
    cvt8_finish(j, wscale, nullptr, scr, item, lane, v);
}
__device__ __forceinline__ void cvt8_range(const CvtJob& j, float wscale, const LAS float* gtab, LAS float* scr, int lo, int hi, int gw, int NGW, int lane) {
    int it = lo + gw; if (it >= hi) return;
    float va[64], vb[64]; cvt8_load(j, it, lane, va);
    for (;;) {
        int nx = it + NGW; bool hn = nx < hi;
        if (hn) cvt8_load(j, nx, lane, vb);
        cvt8_finish(j, wscale, gtab, scr, it, lane, va);
        if (!hn) break;
        it = nx; nx = it + NGW; hn = nx < hi;
        if (hn) cvt8_load(j, nx, lane, va);
        cvt8_finish(j, wscale, gtab, scr, it, lane, vb);
        if (!hn) break;
        it = nx;
    }
}
#ifndef FP8_PLE1
#define FP8_PLE1 true
#endif
#ifndef FP8_PLE0
#define FP8_PLE0 true
#endif
#ifndef FP8_QKV
#define FP8_QKV true
#endif
#ifndef FP8_FFN
#define FP8_FFN true
#endif
constexpr float WSC_GU = 1024.0f, WSC_DN = 2048.0f, ASC_X = 16.0f, ASC_ACT = 8.0f;
typedef float v4f __attribute__((ext_vector_type(4)));
__device__ __forceinline__ void cvtd_load(const CvtJob& j, int item, bool ok, int lane, v4f (&v)[16]) {
    const int nblk = j.N / 32, kpg = j.Kg / 128; const int kb = item / nblk, nb = item - kb * nblk, grp = kb / kpg, kl = kb - grp * kpg, k0 = 128 * kl, n0 = 32 * nb;
    const size_t rs = ok ? (size_t)j.ld : 0;
    const float* src = j.W + (ok ? (size_t)grp * j.Kg * j.ld + (size_t)(k0 + 16 * (lane >> 3)) * j.ld + n0 : (size_t)0) + 4 * (lane & 7);
#pragma unroll
    for (int i = 0; i < 16; ++i) v[i] = __builtin_nontemporal_load((const v4f*)(src + (size_t)i * rs));
}
__device__ __forceinline__ void cvtd_finish(const CvtJob& j, float wscale, bool useg, const LAS float* gtab, int item, int lane, const v4f (&v)[16]) {
    const int nblk = j.N / 32, kpg = j.Kg / 128; const int kb = item / nblk, nb = item - kb * nblk, grp = kb / kpg, kl = kb - grp * kpg, k0 = 128 * kl, n0 = 32 * nb;
    const int r = lane >> 3, cc = lane & 7; const int d0 = map_col(j.map, j.F, n0);
    unsigned char* D = (unsigned char*)j.dst + (size_t)grp * j.N * j.Kg + (size_t)(d0 + 4 * cc) * j.Kg + k0 + 16 * r;
    float g[16];
    if (useg) {
#pragma unroll
        for (int m = 0; m < 4; ++m) { const v4f t = *(const LAS v4f*)(gtab + k0 + 16 * r + 4 * m); g[4 * m] = t[0]; g[4 * m + 1] = t[1]; g[4 * m + 2] = t[2]; g[4 * m + 3] = t[3]; }
    } else {
#pragma unroll
        for (int i = 0; i < 16; ++i) g[i] = wscale;
    }
#pragma unroll
    for (int q = 0; q < 4; ++q) {
        v4u o; o.x = pg8::pk4_fp8(v[0][q] * g[0], v[1][q] * g[1], v[2][q] * g[2], v[3][q] * g[3]); o.y = pg8::pk4_fp8(v[4][q] * g[4], v[5][q] * g[5], v[6][q] * g[6], v[7][q] * g[7]);
        o.z = pg8::pk4_fp8(v[8][q] * g[8], v[9][q] * g[9], v[10][q] * g[10], v[11][q] * g[11]); o.w = pg8::pk4_fp8(v[12][q] * g[12], v[13][q] * g[13], v[14][q] * g[14], v[15][q] * g[15]);
        __builtin_nontemporal_store(o, (GAS v4u*)(D + (size_t)q * j.Kg)); }
}
__device__ __forceinline__ void cvtd_range(const CvtJob& j, float wscale, bool useg, const LAS float* gtab, int first, int hi, int NGW, int lane) {
    int it = first; if (it >= hi) return;
    int nl = it;
    v4f va[16], vb[16], vc[16];
#define CVTD_LOADN(v) do { cvtd_load(j, nl, nl < hi, lane, v); nl += NGW; } while (0)
    CVTD_LOADN(va); CVTD_LOADN(vb);
    for (;;) {
        CVTD_LOADN(vc); cvtd_finish(j, wscale, useg, gtab, it, lane, va); it += NGW; if (it >= hi) break;
        CVTD_LOADN(va); cvtd_finish(j, wscale, useg, gtab, it, lane, vb); it += NGW; if (it >= hi) break;
        CVTD_LOADN(vb); cvtd_finish(j, wscale, useg, gtab, it, lane, vc); it += NGW; if (it >= hi) break;
    }
#undef CVTD_LOADN
}
#ifndef PROBE_CVTREP
#define PROBE_CVTREP 1
#endif
#ifndef BG_B1
#define BG_B1 18
#define BG_B2 36
#define BG_B3 56
#define BG_B4 84
#endif
#ifndef BGCVT
#define BGCVT 4
#endif
static_assert(FP8_FFN && FP8_PLE0 && FP8_PLE1 && FP8_QKV && FP8_WO, "the background conversion list assumes these weights are fp8");
__device__ __forceinline__ void bg_job(int jb, unsigned char* ws, CvtJob& j, float& wscale, const float*& gain) {
    switch (jb) {
    case 0:  j = CvtJob{arg_in(15), 2 * DFF, DM, 1, 2 * DFF, nullptr, 2, DFF, (bf16*)(ws + WS_WGU)}; wscale = WSC_GU; gain = arg_in(3); break;
    case 1:  j = CvtJob{arg_in(16), DM, DFF, 1, DM, nullptr, 0, 0, (bf16*)(ws + WS_WFD)}; wscale = WSC_DN; gain = nullptr; break;
    case 2:  j = CvtJob{arg_in(21), DM, DM, 1, DM, nullptr, 0, 0, (bf16*)(ws + WS_WPG)}; wscale = WSC_GU; gain = arg_in(4); break;
    case 3:  j = CvtJob{arg_in(12), DM, DM, 1, DM, nullptr, 0, 0, (bf16*)(ws + WS_WQKV)}; wscale = WSC_GU; gain = arg_in(2) + DM; break;
    case 4:  j = CvtJob{arg_in(9), 2 * DM + NH, DM, 1, 2 * DM, nullptr, 0, 0, (bf16*)(ws + WS_WQKV + (size_t)DM * DM)}; wscale = WSC_GU; gain = arg_in(8); break;
    case 5:  j = CvtJob{arg_in(14), DM, DM, 1, DM, nullptr, 0, 0, (bf16*)(ws + WS_WO)}; wscale = WSC_GU; gain = nullptr; break;
    case 6:  j = CvtJob{arg_in(21) + (size_t)DM * DM, DM, DM, 1, DM, nullptr, 0, 0, (bf16*)(ws + WS_WPG) + (size_t)DM * DM}; wscale = WSC_GU; gain = arg_in(4) + DM; break;
    case 7:  j = CvtJob{arg_in(18), 2 * DFE, DM, NE, 2 * DFE, nullptr, 2, DFE, (bf16*)(ws + WS_WMGU)}; wscale = WSC_GU; gain = arg_in(3) + DM; break;
    default: j = CvtJob{arg_in(19), DM, DFE, NE, DM, nullptr, 0, 0, (bf16*)(ws + WS_WMD)}; wscale = WSC_DN; gain = nullptr; break;
    }
}
constexpr int BG_IGU = NE * (DM / 128) * (2 * DFE / 32), BG_IDN = NE * (DFE / 128) * (DM / 32), BG_I1K = (DM / 128) * (DM / 32);
constexpr int BG_GA = 11264, BG_GB = 35840;
constexpr int BG_NSEG = 11;
constexpr int BG_SEGJOB[BG_NSEG] = {0, 1, 2, 3, 4, 7, 7, 5, 6, 7, 8};
constexpr int BG_SEGLO[BG_NSEG]  = {0, 0, 0, 0, 0, 0, BG_GA, 0, 0, BG_GB, 0};
constexpr int BG_SEGN[BG_NSEG]   = {(DM / 128) * (2 * DFF / 32), (DFF / 128) * (DM / 32), BG_I1K, BG_I1K, (DM / 128) * (2 * DM / 32), BG_GA, BG_GB - BG_GA, BG_I1K, BG_I1K, BG_IGU - BG_GB, BG_IDN};
constexpr int BG_SLOT[5] = {0, 6, 7, 10, 11};
__device__ __forceinline__ void moe_cvt_slot(Frame& F, int s, int nslot) {
    int lane = F.lane, wave = F.wave, tid = F.tid;
    asm volatile("" : "+v"(lane)); asm volatile("" : "+s"(wave)); asm volatile("" : "+v"(tid));
    const int gw = F.vcu * NWAVES + wave, NGW = F.G * NWAVES;
    unsigned char* ws = F.ws;
    LAS float* gtab = (LAS float*)(F.lds + RING_OFF);
    int sg0 = BG_SLOT[0], sg1 = BG_SLOT[4];
#pragma unroll
    for (int k = 0; k < 4; ++k) if (nslot > 1 && s == k) { sg0 = BG_SLOT[k]; sg1 = BG_SLOT[k + 1]; }
    int vbase = 0;
#pragma nounroll
    for (int sg = sg0; sg < sg1; ++sg) {
        int q = sg; asm volatile("" : "+s"(q));
        int jb = 0, slo = 0, sn = 0;
#pragma unroll
        for (int k = 0; k < BG_NSEG; ++k) if (q == k) { jb = BG_SEGJOB[k]; slo = BG_SEGLO[k]; sn = BG_SEGN[k]; }
        CvtJob j; float wscale; const float* gain; bg_job(jb, ws, j, wscale, gain);
        __syncthreads();
        if (gain) { for (int i = tid; i < DM; i += NWAVES * 64) gtab[i] = gain[i] * wscale; }
        LDS_WAIT(); __syncthreads();
        int i0 = (gw - vbase) % NGW; if (i0 < 0) i0 += NGW;
        cvtd_range(j, wscale, gain != nullptr, gtab, slo + i0, slo + sn, NGW, lane);
        vbase += sn;
    }
    LDS_WAIT(); __syncthreads();
}
__device__ __forceinline__ void p0_prologue(Frame& F) {
    LAS float* scr = (LAS float*)(F.lds + RING_OFF + F.wave * 17408);
    const int gw = F.vcu * NWAVES + F.wave, NGW = F.G * NWAVES;
    unsigned char* ws = F.ws;
    constexpr int I0 = (DM / 64) * (3 * DM / 32), I1 = (DM / 64) * (DM / 32), I2 = (DM / (FP8_FFN ? 128 : 64)) * (2 * DFF / 32), I3 = (DFF / (FP8_FFN ? 128 : 64)) * (DM / 32), I4A = (DM / (FP8_PLE0 ? 128 : 64)) * (DM / 32), I4B = FP8_PLE1 ? (DM / 128) * (DM / 32) : I4A, I4 = I4A + I4B, I5 = 2 * (PLE / 64) * (DM / 32),
                  I6 = FP8_QKV ? (DM / 128) * (DM / 32) : I1, I7 = (DM / (FP8_QKV ? 128 : 64)) * (2 * DM / 32), I8 = FP8_WO ? (DM / 128) * (DM / 32) : I1, I9P = (DM / 128) * (2 * DFE / 32), I9 = NE * I9P, I10 = NE * (DFE / 128) * (DM / 32);
    constexpr int NITEMS = I0 + I1 + I5;
    for (int it = gw; it < NITEMS; it += NGW) {
        int r = it;
        if (r < I0) { const CvtJob j{arg_in(5), 3 * DM, DM, 1, 3 * DM, arg_in(2), 1, 0, (bf16*)(ws + WS_WCI)}; cvt_item(j, scr, r, F.lane); continue; } r -= I0;
        if (r < I1) { const CvtJob j{arg_in(7), DM, DM, 1, DM, nullptr, 0, 0, (bf16*)(ws + WS_WCO)}; cvt_item(j, scr, r, F.lane); continue; } r -= I1;
        { const CvtJob j{arg_in(20), DM, PLE, 2, DM, nullptr, 0, 0, (bf16*)(ws + WS_WPU)}; cvt_item(j, scr, r, F.lane); }
        (void)I2; (void)I3; (void)I4; (void)I6; (void)I7; (void)I8; (void)I9P; (void)I9; (void)I10;
    }
    static_assert(BGCVT == 4, "the fp8 weights are converted by the four background slots only");
    {
        const int gt = gw * 64 + F.lane, NGT = NGW * 64;
        float* Wf = (float*)(ws + WS_WF); float* Wr = (float*)(ws + WS_WR);
        for (int i = gt; i < NH * DM; i += NGT) { const int h = i / DM, k = i - h * DM; Wf[i] = arg_in(8)[k] * arg_in(9)[(size_t)k * (2 * DM + NH) + 2 * DM + h]; }
        for (int i = gt; i < DM * NE; i += NGT) { const int k = i / NE; Wr[i] = arg_in(3)[DM + k] * arg_in(17)[i]; }
        const f32x4* p4 = (const f32x4*)arg_in(1); unsigned long long* pb = (unsigned long long*)(ws + WS_PB);
#pragma unroll 8
        for (int i = gt; i < 2 * T * PLE / 4; i += NGT) { const f32x4 v = p4[i]; pb[i] = (unsigned long long)pk2(v[0], v[1]) | ((unsigned long long)pk2(v[2], v[3]) << 32); }
    }
    {
        const float* x = arg_in(0); bf16* hb = (bf16*)(ws + WS_HB); float* rstd0 = (float*)(ws + WS_RSTD);
        for (int mb = gw; mb < T; mb += 4 * NGW) {
            f32x4 v[4][4][2];
#pragma unroll
            for (int t = 0; t < 4; ++t) { const int m = (mb + t * NGW < T) ? mb + t * NGW : mb; const f32x4* xr = (const f32x4*)(x + (size_t)m * DM) + 2 * F.lane;
#pragma unroll
                for (int j = 0; j < 4; ++j) { v[t][j][0] = xr[128 * j]; v[t][j][1] = xr[128 * j + 1]; } }
#pragma unroll
            for (int t = 0; t < 4; ++t) { if (mb + t * NGW >= T) break; const int m = mb + t * NGW; float s = 0.f;
#pragma unroll
                for (int j = 0; j < 4; ++j) s += (v[t][j][0][0] * v[t][j][0][0] + v[t][j][0][1] * v[t][j][0][1]) + (v[t][j][0][2] * v[t][j][0][2] + v[t][j][0][3] * v[t][j][0][3]) + (v[t][j][1][0] * v[t][j][1][0] + v[t][j][1][1] * v[t][j][1][1]) + (v[t][j][1][2] * v[t][j][1][2] + v[t][j][1][3] * v[t][j][1][3]);
                s = wave_sum(s);
                if (F.lane == 0) rstd0[m] = 1.0f / sqrtf(s * (1.0f / DM) + RMS_EPS);
                v4u* o = (v4u*)(hb + (size_t)m * DM) + F.lane;
#pragma unroll
                for (int j = 0; j < 4; ++j) { v4u w; w.x = pk2(v[t][j][0][0], v[t][j][0][1]); w.y = pk2(v[t][j][0][2], v[t][j][0][3]); w.z = pk2(v[t][j][1][0], v[t][j][1][1]); w.w = pk2(v[t][j][1][2], v[t][j][1][3]); o[64 * j] = w; } }
        }
    }
}

__device__ __forceinline__ void p3_conv(Frame& F) {
    const int gw = F.vcu * NWAVES + F.wave, NGW = F.G * NWAVES;
    const bf16* U = (const bf16*)(F.ws + WS_U); const bf16* BG = (const bf16*)(F.ws + WS_BG); bf16* Y = (bf16*)(F.ws + WS_YB);
    const float* wd = arg_in(6);
    for (int it = gw; it < (T / 16) * 4; it += NGW) {
        const int strip = it >> 2, cq = it & 3, t0 = strip * 16, c0 = cq * 512 + F.lane * 8;
        float w0[8], w1[8], w2[8];
#pragma unroll
        for (int j = 0; j < 8; ++j) { w0[j] = wd[c0 + j]; w1[j] = wd[DM + c0 + j]; w2[j] = wd[2 * DM + c0 + j]; }
        float um2[8], um1[8];
        const bool first = (t0 % SEQ) == 0;
        if (first) {
#pragma unroll
            for (int j = 0; j < 8; ++j) { um2[j] = 0.f; um1[j] = 0.f; }
        } else {
            const v4u a = *(const v4u*)(U + (size_t)(t0 - 2) * DM + c0), b = *(const v4u*)(U + (size_t)(t0 - 1) * DM + c0);
            um2[0] = pg8::bf_lo(a.x); um2[1] = pg8::bf_hi(a.x); um2[2] = pg8::bf_lo(a.y); um2[3] = pg8::bf_hi(a.y); um2[4] = pg8::bf_lo(a.z); um2[5] = pg8::bf_hi(a.z); um2[6] = pg8::bf_lo(a.w); um2[7] = pg8::bf_hi(a.w);
            um1[0] = pg8::bf_lo(b.x); um1[1] = pg8::bf_hi(b.x); um1[2] = pg8::bf_lo(b.y); um1[3] = pg8::bf_hi(b.y); um1[4] = pg8::bf_lo(b.z); um1[5] = pg8::bf_hi(b.z); um1[6] = pg8::bf_lo(b.w); um1[7] = pg8::bf_hi(b.w);
        }
        v4u ua[16], ga[16];
#pragma unroll
        for (int r = 0; r < 16; ++r) { ua[r] = *(const v4u*)(U + (size_t)(t0 + r) * DM + c0); ga[r] = *(const v4u*)(BG + (size_t)(t0 + r) * DM + c0); }
#pragma unroll
        for (int r = 0; r < 16; ++r) {
            const v4u a = ua[r], g = ga[r];
            float u0[8], gg[8], y[8];
            u0[0] = pg8::bf_lo(a.x); u0[1] = pg8::bf_hi(a.x); u0[2] = pg8::bf_lo(a.y); u0[3] = pg8::bf_hi(a.y); u0[4] = pg8::bf_lo(a.z); u0[5] = pg8::bf_hi(a.z); u0[6] = pg8::bf_lo(a.w); u0[7] = pg8::bf_hi(a.w);
            gg[0] = pg8::bf_lo(g.x); gg[1] = pg8::bf_hi(g.x); gg[2] = pg8::bf_lo(g.y); gg[3] = pg8::bf_hi(g.y); gg[4] = pg8::bf_lo(g.z); gg[5] = pg8::bf_hi(g.z); gg[6] = pg8::bf_lo(g.w); gg[7] = pg8::bf_hi(g.w);
#pragma unroll
            for (int j = 0; j < 8; ++j) { y[j] = gg[j] * (w0[j] * um2[j] + w1[j] * um1[j] + w2[j] * u0[j]); um2[j] = um1[j]; um1[j] = u0[j]; }
            v4u o; o.x = pk2(y[0], y[1]); o.y = pk2(y[2], y[3]); o.z = pk2(y[4], y[5]); o.w = pk2(y[6], y[7]);
            *(v4u*)(Y + (size_t)(t0 + r) * DM + c0) = o;
        }
    }
}

__device__ __forceinline__ void p9_flogit(Frame& F, const bf16* hb, const float* slots) {
    typedef short bf16x8_t __attribute__((ext_vector_type(8)));
    const int gw = F.vcu * NWAVES + F.wave, NGW = F.G * NWAVES;
    const float* Wf = (const float*)(F.ws + WS_WF); float* LF = (float*)(F.ws + WS_LF);
    const int nper = (NGW >= 4 * (T / 16)) ? 4 : 1;
    if (gw % nper != 0) return;
    for (int task = gw / nper; task < T / 16; task += NGW / nper) {
        const int t0 = task * 16, r16 = F.lane & 15, kq = F.lane >> 4;
        float ssq = 0.f; { const f32x4* sp = (const f32x4*)(slots + (size_t)(t0 + (F.lane >> 2)) * 32 + (F.lane & 3) * 8); const f32x4 u = sp[0], v = sp[1]; ssq = ((u[0] + u[1]) + (u[2] + u[3])) + ((v[0] + v[1]) + (v[2] + v[3])); }
        ssq += __shfl_xor(ssq, 1); ssq += __shfl_xor(ssq, 2);
        const float rstd_l = 1.0f / sqrtf(ssq * (1.0f / DM) + RMS_EPS);
        const bf16* ap = hb + (size_t)(t0 + r16) * DM + kq * 8; const float* bp = Wf + (size_t)r16 * DM + kq * 8;
        f32x4 acc = {0.f, 0.f, 0.f, 0.f};
#pragma unroll 8
        for (int ks = 0; ks < DM / 32; ++ks) {
            const bf16x8_t af = *(const bf16x8_t*)(ap + ks * 32);
            const f32x4 b0 = *(const f32x4*)(bp + ks * 32), b1 = *(const f32x4*)(bp + ks * 32 + 4);
            v4u bw; bw.x = pk2(b0[0], b0[1]); bw.y = pk2(b0[2], b0[3]); bw.z = pk2(b1[0], b1[1]); bw.w = pk2(b1[2], b1[3]);
            acc = __builtin_amdgcn_mfma_f32_16x16x32_bf16(af, __builtin_bit_cast(bf16x8_t, bw), acc, 0, 0, 0);
        }
        const float bfh = arg_in(10)[r16]; f32x4 o;
#pragma unroll
        for (int j = 0; j < 4; ++j) { const float rs = __shfl(rstd_l, 4 * (4 * kq + j)); const float f = rs * acc[j] + bfh;
            o[j] = (f >= 0.f) ? -log1pf(expf(-f)) : f - log1pf(expf(f)); }
        const int tq = t0 + 4 * kq, bb = tq / SEQ, sq = tq - bb * SEQ;
        *(f32x4*)(LF + ((size_t)bb * NH + r16) * SEQ + sq) = o;
    }
}
struct RouteBufs { int* e; float* w; int* rank; int* row; int* hist; };
__device__ __forceinline__ RouteBufs route_bufs(unsigned char* ws) { RouteBufs r; unsigned char* b = ws + WS_ROUTE; r.e = (int*)b; r.w = (float*)(b + 65536); r.rank = (int*)(b + 131072); r.row = (int*)(b + 196608); r.hist = (int*)(b + 262144); return r; }
__device__ __forceinline__ void p13_route(Frame& F) {
    const bf16* h = (const bf16*)(F.ws + WS_HB); const float* Wr = (const float*)(F.ws + WS_WR); float* rstd4 = (float*)(F.ws + WS_RSTD) + T;
    const RouteBufs R = route_bufs(F.ws);
    LAS int* le = (LAS int*)(F.lds + RING_OFF);
    for (int ch = F.vcu; ch < T / 32; ch += F.G) {
        {
            const int m0 = ch * 32 + F.wave * 4;
            float ss[4] = {0.f, 0.f, 0.f, 0.f}; float lg[32];
#pragma unroll
            for (int k = 0; k < 32; ++k) lg[k] = 0.f;
#pragma unroll
            for (int j = 0; j < 4; ++j) { const int c8 = j * 64 + F.lane; v4u a[4];
#pragma unroll
                for (int i = 0; i < 4; ++i) a[i] = *((const v4u*)(h + (size_t)(m0 + i) * DM) + c8);
                const f32x4* wp = (const f32x4*)(Wr + (size_t)c8 * 8 * NE);
#pragma unroll
                for (int q = 0; q < 8; ++q) { const f32x4 wa = wp[2 * q], wb = wp[2 * q + 1];
#pragma unroll
                    for (int i = 0; i < 4; ++i) { const unsigned wd = (q < 2) ? a[i].x : (q < 4) ? a[i].y : (q < 6) ? a[i].z : a[i].w; const float v = (q & 1) ? pg8::bf_hi(wd) : pg8::bf_lo(wd);
                        ss[i] += v * v;
                        lg[8 * i + 0] += v * wa[0]; lg[8 * i + 1] += v * wa[1]; lg[8 * i + 2] += v * wa[2]; lg[8 * i + 3] += v * wa[3]; lg[8 * i + 4] += v * wb[0]; lg[8 * i + 5] += v * wb[1]; lg[8 * i + 6] += v * wb[2]; lg[8 * i + 7] += v * wb[3]; } } }
            const float tot = reduce32(lg, F.lane);
#pragma unroll
            for (int i = 0; i < 4; ++i) {
                const float ssum = wave_sum(ss[i]); const float rstd = 1.0f / sqrtf(ssum * (1.0f / DM) + RMS_EPS);
                float l8[NE];
#pragma unroll
                for (int e = 0; e < NE; ++e) l8[e] = __uint_as_float(__builtin_amdgcn_readlane(__float_as_uint(tot), 2 * (8 * i + e)));
                int e1 = 0; float v1 = l8[0];
#pragma unroll
                for (int e = 1; e < NE; ++e) if (l8[e] > v1) { v1 = l8[e]; e1 = e; }
                int e2 = -1; float v2 = -3.0e38f;
#pragma unroll
                for (int e = 0; e < NE; ++e) if (e != e1 && l8[e] > v2) { v2 = l8[e]; e2 = e; }
                const float w1 = 1.0f / (1.0f + expf((v2 - v1) * rstd)), w2 = 1.0f - w1;
                const int tl = F.wave * 4 + i, m = m0 + i;
                if (F.lane == 0) { rstd4[m] = rstd; R.e[2 * m] = e1; R.e[2 * m + 1] = e2; R.w[2 * m] = w1; R.w[2 * m + 1] = w2; le[2 * tl] = e1; le[2 * tl + 1] = e2; }
            }
        }
        LDS_WAIT(); __syncthreads();
        if (F.wave == 0) { const int ei = le[F.lane]; int rank = 0;
#pragma unroll
            for (int e = 0; e < NE; ++e) { const unsigned long long mk = __ballot(ei == e); if (ei == e) rank = __popcll(mk & ((1ull << F.lane) - 1ull)); if (F.lane == 0) R.hist[ch * NE + e] = __popcll(mk); }
            R.rank[ch * 64 + F.lane] = rank; }
        __syncthreads();
    }
}
__device__ __forceinline__ void p14_gather(Frame& F, const bf16* hb) {
    const RouteBufs R = route_bufs(F.ws); const float* rstd4 = (const float*)(F.ws + WS_RSTD) + T;
    bf16* XG = (bf16*)(F.ws + WS_XG);
    LAS int* sm = (LAS int*)(F.lds + RING_OFF + 1024);
    for (int ch = F.vcu; ch < T / 32; ch += F.G) {
        { const int e = F.wave; int below = 0, tot = 0;
#pragma unroll
            for (int q = 0; q < 4; ++q) { const int c2 = q * 64 + F.lane; const int v = R.hist[c2 * NE + e]; tot += v; below += (c2 < ch) ? v : 0; }
#pragma unroll
            for (int o = 1; o < 64; o <<= 1) { tot += __shfl_xor(tot, o); below += __shfl_xor(below, o); }
            if (F.lane == 0) { sm[e] = below; sm[8 + e] = tot; } }
        LDS_WAIT(); __syncthreads();
        if (F.tid == 0) { int s = 0; for (int e = 0; e < NE; ++e) { sm[16 + e] = s; s += (sm[8 + e] + 255) / 256 * 256; } }
        LDS_WAIT(); __syncthreads();
        {
            const int m0 = ch * 32 + F.wave * 4; v4u ra[4][2][2];
#pragma unroll
            for (int i = 0; i < 4; ++i) { const v4u* src = (const v4u*)(hb + (size_t)(m0 + i) * DM);
#pragma unroll
                for (int q = 0; q < 2; ++q) { ra[i][q][0] = src[2 * (q * 64 + F.lane)]; ra[i][q][1] = src[2 * (q * 64 + F.lane) + 1]; } }
#pragma unroll
            for (int i = 0; i < 4; ++i) { const int tl = F.wave * 4 + i, m = m0 + i; const float xs = rstd4[m] * ASC_X; v4u o[2];
#pragma unroll
                for (int q = 0; q < 2; ++q) { const v4u a = ra[i][q][0], b = ra[i][q][1];
                    o[q].x = pg8::pk4_fp8(pg8::bf_lo(a.x) * xs, pg8::bf_hi(a.x) * xs, pg8::bf_lo(a.y) * xs, pg8::bf_hi(a.y) * xs); o[q].y = pg8::pk4_fp8(pg8::bf_lo(a.z) * xs, pg8::bf_hi(a.z) * xs, pg8::bf_lo(a.w) * xs, pg8::bf_hi(a.w) * xs);
                    o[q].z = pg8::pk4_fp8(pg8::bf_lo(b.x) * xs, pg8::bf_hi(b.x) * xs, pg8::bf_lo(b.y) * xs, pg8::bf_hi(b.y) * xs); o[q].w = pg8::pk4_fp8(pg8::bf_lo(b.z) * xs, pg8::bf_hi(b.z) * xs, pg8::bf_lo(b.w) * xs, pg8::bf_hi(b.w) * xs); }
#pragma unroll
                for (int k = 0; k < 2; ++k) { const int e = R.e[2 * m + k]; const int dst = sm[16 + e] + sm[e] + R.rank[ch * 64 + 2 * tl + k];
                    v4u* d = (v4u*)((unsigned char*)XG + (size_t)dst * DM); d[F.lane] = o[0]; d[64 + F.lane] = o[1];
                    if (F.lane == 0) R.row[2 * m + k] = dst; } }
        }
        { const int e = F.wave, tot = sm[8 + e], padn = (256 - (tot & 255)) & 255;
          if (ch < padn) { const int dst = sm[16 + e] + tot + ch; v4u* d = (v4u*)((unsigned char*)XG + (size_t)dst * DM); const v4u z = {0u, 0u, 0u, 0u};
#pragma unroll
              for (int q = 0; q < 2; ++q) d[q * 64 + F.lane] = z;
              }
          if (ch == 0 && F.lane == 0) ((int*)(F.ws + WS_ROUTE + 300000))[e] = (tot + 255) / 256; }
        __syncthreads();
    }
}
__device__ __forceinline__ void p17_combine(Frame& F, const bf16* hin, bf16* hb, unsigned char* h8) {
    const int gw = F.vcu * NWAVES + F.wave, NGW = F.G * NWAVES;
    const RouteBufs R = route_bufs(F.ws); const bf16* YM = (const bf16*)(F.ws + WS_YM); float* rstd5 = (float*)(F.ws + WS_RSTD) + 2 * T;
    for (int mb = gw; mb < T; mb += 2 * NGW) {
        int mm[2], r0[2], r1[2]; float w0[2], w1[2];
#pragma unroll
        for (int t = 0; t < 2; ++t) { int m = (mb + t * NGW < T) ? mb + t * NGW : mb; if (4 * NGW == T) m = 4 * (m % NGW) + m / NGW;
            mm[t] = m; r0[t] = R.row[2 * m]; r1[t] = R.row[2 * m + 1]; w0[t] = R.w[2 * m]; w1[t] = R.w[2 * m + 1]; }
        v4u ya[2][4], yb[2][4], hh[2][4];
#pragma unroll
        for (int t = 0; t < 2; ++t) { const v4u* hr = (const v4u*)(hin + (size_t)mm[t] * DM) + F.lane; const v4u* y0 = (const v4u*)(YM + (size_t)r0[t] * DM) + F.lane; const v4u* y1 = (const v4u*)(YM + (size_t)r1[t] * DM) + F.lane;
#pragma unroll
            for (int j = 0; j < 4; ++j) { ya[t][j] = y0[64 * j]; yb[t][j] = y1[64 * j]; hh[t][j] = hr[64 * j]; } }
#pragma unroll
        for (int t = 0; t < 2; ++t) {
            if (t == 1 && mb + NGW >= T) break;
            const int m = mm[t]; const float a0w = w0[t], a1w = w1[t];
            float s = 0.f; v4u* o = (v4u*)(hb + (size_t)m * DM) + F.lane; f32x4 keep[4][2];
#pragma unroll
            for (int j = 0; j < 4; ++j) { const v4u A = ya[t][j], B = yb[t][j], H = hh[t][j];
                f32x4 a, b;
                a[0] = pg8::bf_lo(H.x) + (a0w * pg8::bf_lo(A.x) + a1w * pg8::bf_lo(B.x)); a[1] = pg8::bf_hi(H.x) + (a0w * pg8::bf_hi(A.x) + a1w * pg8::bf_hi(B.x)); a[2] = pg8::bf_lo(H.y) + (a0w * pg8::bf_lo(A.y) + a1w * pg8::bf_lo(B.y)); a[3] = pg8::bf_hi(H.y) + (a0w * pg8::bf_hi(A.y) + a1w * pg8::bf_hi(B.y));
                b[0] = pg8::bf_lo(H.z) + (a0w * pg8::bf_lo(A.z) + a1w * pg8::bf_lo(B.z)); b[1] = pg8::bf_hi(H.z) + (a0w * pg8::bf_hi(A.z) + a1w * pg8::bf_hi(B.z)); b[2] = pg8::bf_lo(H.w) + (a0w * pg8::bf_lo(A.w) + a1w * pg8::bf_lo(B.w)); b[3] = pg8::bf_hi(H.w) + (a0w * pg8::bf_hi(A.w) + a1w * pg8::bf_hi(B.w));
                s += (a[0] * a[0] + a[1] * a[1]) + (a[2] * a[2] + a[3] * a[3]) + (b[0] * b[0] + b[1] * b[1]) + (b[2] * b[2] + b[3] * b[3]);
                v4u w; w.x = pk2(a[0], a[1]); w.y = pk2(a[2], a[3]); w.z = pk2(b[0], b[1]); w.w = pk2(b[2], b[3]); o[64 * j] = w; keep[j][0] = a; keep[j][1] = b; }
            s = wave_sum(s);
            const float rstd = 1.0f / sqrtf(s * (1.0f / DM) + RMS_EPS);
            if (F.lane == 0) rstd5[m] = rstd;
            if (h8) { const float xs = rstd * ASC_X; typedef unsigned u32x2 __attribute__((ext_vector_type(2)));
#pragma unroll
                for (int j = 0; j < 4; ++j) { u32x2 w; w.x = pg8::pk4_fp8(keep[j][0][0] * xs, keep[j][0][1] * xs, keep[j][0][2] * xs, keep[j][0][3] * xs); w.y = pg8::pk4_fp8(keep[j][1][0] * xs, keep[j][1][1] * xs, keep[j][1][2] * xs, keep[j][1][3] * xs);
                    *((u32x2*)(h8 + (size_t)m * DM) + 64 * j + F.lane) = w; } }
        }
    }
}

#ifndef MK_PER_PHASE
#define MK_PER_PHASE 0
#endif
constexpr int NPHASE = 19;
struct Args { const float* in[22]; float* out; unsigned char* ws; int ph_lo, ph_hi; };
static_assert(sizeof(Args) == 24 * 8 + 8, "Args has no padding");

__global__ void __launch_bounds__(NWAVES * 64, 2) yoco_fwd(Args args) {
    extern __shared__ __attribute__((aligned(16))) unsigned char lds[];
    Frame F;
    F.lds = (LAS unsigned char*)lds;
    F.MISC = (volatile LAS unsigned*)(F.lds + MISC_OFF);
    F.tab = (LAS float*)(F.lds + TAB_OFF);
    F.tid = threadIdx.x; F.lane = F.tid & 63; F.wave = __builtin_amdgcn_readfirstlane(F.tid >> 6);
    F.G = gridDim.x; { const int bx = blockIdx.x; F.vcu = (F.G % 8 == 0) ? (bx % 8) * (F.G / 8) + bx / 8 : bx; }
    unsigned char* ws = args.ws; F.ws = ws; F.out = args.out;
    F.ctl = (gu32*)(ws + WS_CTL);
    for (int u = F.tid; u < (LDS_BYTES - MISC_OFF) / 4; u += NWAVES * 64) ((LAS unsigned*)(F.lds + MISC_OFF))[u] = 0u;
    __syncthreads();
    XcdBarrier bar; bar.bar = (unsigned*)(F.ctl + CW_BAR); bar.x = 0; bar.st = nullptr;
    if (!MK_PER_PHASE) bar = xcd_barrier_post((unsigned*)(F.ctl + CW_BAR), F.MISC + 8);
    const int lo = args.ph_lo, hi = args.ph_hi;
#ifndef PHMASK
#define PHMASK 0xFFFFFFFFu
#endif
#ifndef XCD_LOCAL_SEAMS
#define XCD_LOCAL_SEAMS 1
#endif
#ifndef PROBE_DUP
#define PROBE_DUP 0u
#endif
#define REP(k) for (int rep_ = 0; rep_ < (((PROBE_DUP >> (k)) & 1u) ? 2 : 1); ++rep_)
#define IN(k) (((PHMASK >> (k)) & 1u) && lo <= (k) && (k) < hi)
#define SEAM(k) do { if (IN(k) && (IN((k) + 1) || IN((k) + 2) || IN((k) + 3))) xcd_barrier(bar); } while (0)
#define SEAM5 do { if (IN(5) && (IN(6) || IN(7) || IN(8))) xcd_barrier(bar, XCD_LOCAL_SEAMS != 0 && F.G * 32 == T && F.G % 8 == 0 && (((T / 256) * (2 * DFF / 256)) % F.G) % 8 == 0 && T / 256 == 32); } while (0)
#define SEAML(k) do { if (IN(k) && (IN((k) + 1) || IN((k) + 2) || IN((k) + 3))) xcd_barrier(bar, XCD_LOCAL_SEAMS != 0 && F.G * 32 == T); } while (0)
    constexpr int NPOS = 4;
    int npos = NPOS; asm volatile("" : "+s"(npos)); int cgrp = (((int)blockIdx.x >> 3) * NPOS) / ((int)gridDim.x >> 3);
#define HOSTB(slot) _Pragma("nounroll") for (int pos_ = 0; pos_ < npos; ++pos_) { int p_ = pos_; asm volatile("" : "+s"(p_)); \
        if (BGCVT > (slot) && p_ == cgrp) for (int r_ = 0; r_ < PROBE_CVTREP; ++r_) moe_cvt_slot(F, slot, BGCVT); if (p_ < NPOS - 1) {
#define HOSTE } }
#define CVT_AT(slot, atend) do { if (BGCVT > (slot) && ((cgrp & 1) != 0) == (atend)) for (int r_ = 0; r_ < PROBE_CVTREP; ++r_) moe_cvt_slot(F, slot, BGCVT); } while (0)
#define HOSTRANGE(S, upp) do { S.i0 = p_ * (upp); S.iend = p_ == NPOS - 2 ? (1 << 24) : (p_ + 1) * (upp); } while (0)
    const LAS float* tabc = (const LAS float*)F.tab;
    bf16* HB = (bf16*)(ws + WS_HB); bf16* HB2 = (bf16*)(ws + WS_HB2);
    float* rstd0 = (float*)(ws + WS_RSTD); float* rstd5 = rstd0 + 2 * T;
    float* SL1 = (float*)(ws + WS_SL1); float* SL2 = (float*)(ws + WS_SL2); float* SL3 = (float*)(ws + WS_SL3);
    int cid = (int)blockIdx.x;
    using pg8::Gemm; using pg8::StaticOrder; using pg8::GroupedOrder; using pg8::RsNone; using pg8::RsDirect; using pg8::RsSlots;

    if (IN(0)) REP(0) { if (rep_) { VM_WAIT(); __syncthreads(); } p0_prologue(F); } SEAM(0);
    bool xcc_dealt = false;
    if (XCD_LOCAL_SEAMS && !MK_PER_PHASE && F.G * 32 == T) {
        const unsigned uni = __builtin_amdgcn_readfirstlane(F.MISC[8 + 2]), rk = __builtin_amdgcn_readfirstlane(F.MISC[8 + 3]);
        if (uni) { xcc_dealt = true; cid = (int)(rk * 8u + bar.x); F.vcu = (int)(bar.x * (unsigned)(F.G / 8) + rk); cgrp = (int)(rk * NPOS) / (F.G / 8); }
    }
    if (IN(2)) REP(2) { if (rep_) { VM_WAIT(); __syncthreads(); } HOSTB(0)
        Gemm g{HB, (const bf16*)(ws + WS_WCI), T, 3 * DM, DM};
        StaticOrder<RsDirect> S; S.init(T, 3 * DM, F.G, cid); S.rs = RsDirect{rstd0, F.tab}; HOSTRANGE(S, 1);
        pg8::EpiPair<0, true> E{(bf16*)(ws + WS_U), DM, 16, (bf16*)(ws + WS_BG), DM, tabc, 1.0f, 1.0f};
        pg8::gemm_phase<pg8::EpiPair<0, true>, StaticOrder<RsDirect>, true, true>(F.lds + RING_OFF, g, S, E);
        HOSTE
    } SEAM(2);
    if (IN(3)) REP(3) { if (rep_) { VM_WAIT(); __syncthreads(); } p3_conv(F); } SEAML(3);
    if (IN(4)) REP(4) { if (rep_) { VM_WAIT(); __syncthreads(); }
        Gemm g{(const bf16*)(ws + WS_YB), (const bf16*)(ws + WS_WCO), T, DM, DM};
        StaticOrder<RsNone> S; S.init(T, DM, F.G, cid);
        pg8::EpiResid<0, true, false> E{arg_in(0), HB2, SL1, nullptr, tabc, FP8_FFN ? (unsigned char*)(ws + WS_H8) : nullptr, ASC_X, 1.0f};
        pg8::gemm_phase<pg8::EpiResid<0, true, false>, StaticOrder<RsNone>, true, true>(F.lds + RING_OFF, g, S, E);
    } SEAML(4);
    if (IN(5)) REP(5) { if (rep_) { VM_WAIT(); __syncthreads(); } HOSTB(1)
        Gemm g{FP8_FFN ? (const bf16*)(ws + WS_H8) : HB2, (const bf16*)(ws + WS_WGU), T, 2 * DFF, FP8_FFN ? DM / 2 : DM};
        StaticOrder<RsSlots> S; S.init(T, 2 * DFF, F.G, cid); S.rs = RsSlots{SL1, F.tab, FP8_FFN ? 1.0f / (ASC_X * WSC_GU) : 1.0f}; HOSTRANGE(S, 2);
        pg8::EpiPair<1, false, FP8_FFN> E{(bf16*)(ws + WS_ACT), DFF, 1 << 30, nullptr, 0, tabc, FP8_FFN ? ASC_ACT : 1.0f, 1.0f};
        pg8::gemm_phase<pg8::EpiPair<1, false, FP8_FFN>, StaticOrder<RsSlots>, true, true, FP8_FFN>(F.lds + RING_OFF, g, S, E);
        HOSTE
        { const int nwg5 = (T / 256) * (2 * DFF / 256), short_lo = nwg5 % F.G;
          if (short_lo == 0 || cid >= short_lo) {
            Gemm g2{(const bf16*)(ws + WS_PB), (const bf16*)(ws + WS_WPU), 2 * T, DM, PLE};
            pg8::EpiBf16S<false> E2{(bf16*)(ws + WS_E0), DM, 0, 0, tabc, 1.0f};
            if (F.G % 8 == 0 && short_lo % 8 == 0 && T / 256 == 32) {
                pg8::PanelOrder S2{cid % 8, (cid - short_lo) / 8, (F.G - short_lo) / 8, T / 256};
                pg8::gemm_phase<pg8::EpiBf16S<false>, pg8::PanelOrder, true, true>(F.lds + RING_OFF, g2, S2, E2);
            } else {
                const int rt2[NE] = {T / 256, T / 256, 0, 0, 0, 0, 0, 0};
                GroupedOrder<RsNone> S2; S2.init(rt2, DM / 256, short_lo ? F.G - short_lo : F.G, short_lo ? cid - short_lo : cid);
                pg8::gemm_phase<pg8::EpiBf16S<false>, GroupedOrder<RsNone>, true, true>(F.lds + RING_OFF, g2, S2, E2); } } }
    } SEAM5;
    if (IN(6)) {
        Gemm g{(const bf16*)(ws + WS_ACT), (const bf16*)(ws + WS_WFD), T, DM, FP8_FFN ? DFF / 2 : DFF};
        StaticOrder<RsNone> S; S.init(T, DM, F.G, cid);
        pg8::EpiResid<0, false, false> E{HB2, HB, SL2, nullptr, tabc, FP8_PLE0 ? (unsigned char*)(ws + WS_H8B) : nullptr, ASC_X, FP8_FFN ? 1.0f / (ASC_ACT * WSC_DN) : 1.0f};
        pg8::gemm_phase<pg8::EpiResid<0, false, false>, StaticOrder<RsNone>, true, true, FP8_FFN>(F.lds + RING_OFF, g, S, E);
    } SEAML(6);
    if (IN(7)) {
        Gemm g{FP8_PLE0 ? (const bf16*)(ws + WS_H8B) : HB, (const bf16*)(ws + WS_WPG), T, DM, FP8_PLE0 ? DM / 2 : DM};
        StaticOrder<RsSlots> S; S.init(T, DM, F.G, cid); S.rs = RsSlots{SL2, F.tab, FP8_PLE0 ? 1.0f / (ASC_X * WSC_GU) : 1.0f};
        pg8::EpiResid<1, false, false> E{HB, HB2, SL3, (const bf16*)(ws + WS_E0), tabc, FP8_QKV ? (unsigned char*)(ws + WS_H8) : nullptr, ASC_X, 1.0f};
        pg8::gemm_phase<pg8::EpiResid<1, false, false>, StaticOrder<RsSlots>, true, true, FP8_PLE0>(F.lds + RING_OFF, g, S, E);
    } SEAML(7);
    if (IN(8)) REP(8) { if (rep_) { VM_WAIT(); __syncthreads(); }
        Gemm g{FP8_QKV ? (const bf16*)(ws + WS_H8) : HB2, (const bf16*)(ws + WS_WQKV), T, 3 * DM, FP8_QKV ? DM / 2 : DM};
        StaticOrder<RsSlots> S; S.init(T, 3 * DM, F.G, cid); S.rs = RsSlots{SL3, F.tab, FP8_QKV ? 1.0f / (ASC_X * WSC_GU) : 1.0f};
        pg8::EpiQKV E{(bf16*)(ws + WS_Q), (bf16*)(ws + WS_K), (bf16*)(ws + WS_V), arg_in(13), arg_in(11), tabc, (LAS float*)(F.lds + TAB_OFF + 2048)};
        pg8::gemm_phase<pg8::EpiQKV, StaticOrder<RsSlots>, true, true, FP8_QKV>(F.lds + RING_OFF, g, S, E);
        p9_flogit(F, HB2, SL3);
    } SEAM(8);
    if (IN(11)) REP(11) { if (rep_) { VM_WAIT(); __syncthreads(); } CVT_AT(2, false);
        const fox::Ptrs P{(const fox::bf16*)(ws + WS_Q), (const fox::bf16*)(ws + WS_K), (const fox::bf16*)(ws + WS_V), (fox::bf16*)(ws + WS_O), (const float*)(ws + WS_LF)};
        const int total = NB * NH * 4;
        int L = F.vcu;
        if (L < total) {
            int pass = 0, par = 0; fox::BlockRef cur = fox::mk_ref(L, 0); fox::Seam S;
            fox::fox_prime(P, cur, (char*)lds + RING_OFF, S);
            for (;;) {
                const bool more_pass = pass == 0, more_item = L + F.G < total, last = !more_pass && !more_item;
                int Ln = L, passn = pass + 1; if (!more_pass) { passn = 0; Ln = more_item ? L + F.G : L; }
                const fox::BlockRef nxt = last ? cur : fox::mk_ref(Ln, passn);
                fox::fox_block(P, cur, nxt, par, (char*)lds + RING_OFF, S);
                if (last) break;
                cur = nxt; pass = passn; L = Ln; par ^= 1;
            }
        }
        VM_WAIT(); CVT_AT(2, true);
    } SEAM(11);
    if (IN(12)) {
        Gemm g{(const bf16*)(ws + WS_O), (const bf16*)(ws + WS_WO), T, DM, FP8_WO ? DM / 2 : DM};
        StaticOrder<RsNone> S; S.init(T, DM, F.G, cid);
        pg8::EpiResid<0, false, false> E{HB2, HB, nullptr, nullptr, tabc, nullptr, 1.0f, FP8_WO ? 1.0f / (16.0f * WSC_GU) : 1.0f};
        pg8::gemm_phase<pg8::EpiResid<0, false, false>, StaticOrder<RsNone>, true, true, FP8_WO>(F.lds + RING_OFF, g, S, E);
    } SEAML(12);
    if (IN(13)) REP(13) { if (rep_) { VM_WAIT(); __syncthreads(); } p13_route(F); } SEAM(13);
    if (IN(14)) REP(14) { if (rep_) { VM_WAIT(); __syncthreads(); } p14_gather(F, HB); } SEAM(14);
    int rts[NE];
    if (IN(15) || IN(16)) {
        const int* rp = (const int*)(ws + WS_ROUTE + 300000);
#pragma unroll
        for (int e = 0; e < NE; ++e) rts[e] = __builtin_amdgcn_readfirstlane((int)__hip_atomic_load((unsigned*)rp + e, RLX_AGENT));
    }
    if (IN(15)) REP(15) { if (rep_) { VM_WAIT(); __syncthreads(); } HOSTB(3)
        Gemm g{(const bf16*)(ws + WS_XG), (const bf16*)(ws + WS_WMGU), MAXROWS, 2 * DFE, DM / 2};
        GroupedOrder<RsNone> S; S.init(rts, 2 * DFE / 256, F.G, cid);
        { const int upp = ((S.nwg + F.G - 1) / F.G + NPOS - 2) / (NPOS - 1); HOSTRANGE(S, upp); }
        pg8::EpiPair<1, false, true, false> E{(bf16*)(ws + WS_ACTM), DFE, 1 << 30, nullptr, 0, tabc, ASC_ACT, 1.0f / (ASC_X * WSC_GU)};
        pg8::gemm_phase<pg8::EpiPair<1, false, true, false>, GroupedOrder<RsNone>, true, true, true>(F.lds + RING_OFF, g, S, E);
        HOSTE
    } SEAM(15);
    if (IN(16)) REP(16) { if (rep_) { VM_WAIT(); __syncthreads(); }
        Gemm g{(const bf16*)(ws + WS_ACTM), (const bf16*)(ws + WS_WMD), MAXROWS, DM, DFE / 2};
        GroupedOrder<RsNone, true> S; S.init(rts, DM / 256, F.G, cid);
        const int nwg = S.nwg, nmain = (nwg / F.G) * F.G, R = nwg - nmain;
        const int Ssp = (R == 0) ? 0 : (R * 14 <= F.G ? 14 : R * 7 <= F.G ? 7 : R * 4 <= F.G ? 4 : R * 2 <= F.G ? 2 : 1);
        S.nlim = nmain;
        constexpr float CS16 = 1.0f / (ASC_ACT * WSC_DN);
        pg8::EpiBf16S<false> E{(bf16*)(ws + WS_YM), DM, 0, 0, tabc, CS16};
        pg8::gemm_phase<pg8::EpiBf16S<false>, GroupedOrder<RsNone, true>, true, true, true>(F.lds + RING_OFF, g, S, E);
        const bool pl = (R % 8 == 0) && (F.G % 8 == 0);
        const int prk = cid >> 3, pxc = cid & 7, prr = pl ? prk / (Ssp ? Ssp : 1) : 0;
        const bool mine = Ssp && (pl ? prr < R / 8 : cid < R * Ssp);
        if (mine) {
            const int ru = pl ? prr * 8 + pxc : cid / Ssp, sl = pl ? prk - prr * Ssp : cid - ru * Ssp, Ks = (DFE / 2) / Ssp, pid = ru * Ssp + sl;
            pg8::OneUnit O1; S.decode(nmain + ru, O1.u); O1.u.par = 0;
            bf16* YP = (bf16*)(ws + WS_YP) + (size_t)pid * 65536;
            Gemm g2{(const bf16*)(ws + WS_ACTM) + (size_t)sl * Ks, (const bf16*)(ws + WS_WMD) + (size_t)sl * Ks, MAXROWS, DM, Ks, DFE / 2};
            pg8::EpiSlab E2{YP, CS16};
            pg8::gemm_phase<pg8::EpiSlab, pg8::OneUnit, true, true, true>(F.lds + RING_OFF, g2, O1, E2);
            unsigned* cnt = (unsigned*)(F.ctl + CW_SPLIT) + 16 * ru;
            VM_WAIT(); __syncthreads();
            if (F.tid == 0) {
                if (!(pl && xcc_dealt)) { __builtin_amdgcn_fence(__ATOMIC_RELEASE, "agent"); asm volatile("s_waitcnt vmcnt(0)" ::: "memory"); }
                (void)__hip_atomic_fetch_add(cnt, 1u, RLX_AGENT);
                unsigned sp = 0; while (__hip_atomic_load(cnt, RLX_AGENT) < (unsigned)Ssp) { __builtin_amdgcn_s_sleep(2); if (++sp > (1u << 22)) break; }
                __builtin_amdgcn_fence(__ATOMIC_ACQUIRE, "agent"); asm volatile("s_waitcnt vmcnt(0)" ::: "memory");
            }
            __syncthreads();
            const int r0 = (256 * sl) / Ssp, r1 = (256 * (sl + 1)) / Ssp;
            const bf16* Y0 = (const bf16*)(ws + WS_YP) + (size_t)(ru * Ssp) * 65536; bf16* YM = (bf16*)(ws + WS_YM);
            for (int idx = F.tid; idx < (r1 - r0) * 32; idx += NWAVES * 64) { const int row = r0 + (idx >> 5), ch = idx & 31; float acc8[8];
#pragma unroll
                for (int q = 0; q < 8; ++q) acc8[q] = 0.f;
                for (int p = 0; p < Ssp; ++p) { const v4u a = *(const v4u*)(Y0 + (size_t)p * 65536 + row * 256 + ch * 8);
                    acc8[0] += pg8::bf_lo(a.x); acc8[1] += pg8::bf_hi(a.x); acc8[2] += pg8::bf_lo(a.y); acc8[3] += pg8::bf_hi(a.y); acc8[4] += pg8::bf_lo(a.z); acc8[5] += pg8::bf_hi(a.z); acc8[6] += pg8::bf_lo(a.w); acc8[7] += pg8::bf_hi(a.w); }
                v4u o; o.x = pk2(acc8[0], acc8[1]); o.y = pk2(acc8[2], acc8[3]); o.z = pk2(acc8[4], acc8[5]); o.w = pk2(acc8[6], acc8[7]);
                *(v4u*)(YM + (size_t)(O1.u.pm * 256 + row) * DM + O1.u.aux * 256 + ch * 8) = o; }
        }
    } SEAM(16);
    if (IN(17)) { p17_combine(F, HB, HB2, FP8_PLE1 ? (unsigned char*)(ws + WS_H8) : nullptr); } SEAML(17);
    if (IN(18)) {
        if (FP8_PLE1) {
            Gemm g{(const bf16*)(ws + WS_H8), (const bf16*)(ws + WS_WPG) + (size_t)DM * DM, T, DM, DM / 2};
            StaticOrder<RsNone> S; S.init(T, DM, F.G, cid);
            pg8::EpiResid<1, false, true, true> E{HB2, F.out, nullptr, (const bf16*)(ws + WS_E1), tabc, nullptr, 1.0f, 1.0f / (ASC_X * WSC_GU)};
            pg8::gemm_phase<pg8::EpiResid<1, false, true, true>, StaticOrder<RsNone>, true, true, true>(F.lds + RING_OFF, g, S, E);
        } else {
            Gemm g{HB2, (const bf16*)(ws + WS_WPG) + (size_t)DM * DM, T, DM, DM};
            StaticOrder<RsDirect> S; S.init(T, DM, F.G, cid); S.rs = RsDirect{rstd5, F.tab};
            pg8::EpiResid<1, false, true> E{HB2, F.out, nullptr, (const bf16*)(ws + WS_E1), tabc, nullptr, 1.0f, 1.0f};
            pg8::gemm_phase<pg8::EpiResid<1, false, true>, StaticOrder<RsDirect>, true, true>(F.lds + RING_OFF, g, S, E);
        }
    }
#undef IN
#undef SEAM
}

extern "C" void kernel_launch(void* const* d_in, const int* in_sizes, int n_in, void* d_out, int out_size, void* d_ws, size_t ws_size, hipStream_t stream) {
    static int grid = 0;
    if (grid == 0) {
        if (n_in != 22 || out_size != T * DM || ws_size < WS_END) { fprintf(stderr, "kernel_launch: unexpected shapes (n_in %d out %d ws %zu need %zu)\n", n_in, out_size, ws_size, (size_t)WS_END); grid = -1; return; }
        int dev = 0, cus = 0, per_cu = 0;
        if (hipGetDevice(&dev) != hipSuccess || hipDeviceGetAttribute(&cus, hipDeviceAttributeMultiprocessorCount, dev) != hipSuccess) { grid = -1; return; }
        if (hipFuncSetAttribute((const void*)yoco_fwd, hipFuncAttributeMaxDynamicSharedMemorySize, LDS_BYTES) != hipSuccess) { fprintf(stderr, "kernel_launch: hipFuncSetAttribute failed\n"); grid = -1; return; }
        if (hipOccupancyMaxActiveBlocksPerMultiprocessor(&per_cu, (const void*)yoco_fwd, NWAVES * 64, LDS_BYTES) != hipSuccess || per_cu < 1) { fprintf(stderr, "kernel_launch: occupancy query says %d\n", per_cu); }
        (void)hipGetLastError();
        grid = cus;
    }
    if (grid < 0) return;
    (void)hipMemsetAsync((char*)d_ws + WS_CTL, 0, CTL_ZERO_BYTES, stream);
    Args a{};
    for (int i = 0; i < 22; ++i) a.in[i] = (const float*)d_in[i];
    a.out = (float*)d_out; a.ws = (unsigned char*)d_ws;
#if MK_PER_PHASE
    for (int p = 0; p < NPHASE; ++p) { a.ph_lo = p; a.ph_hi = p + 1; hipLaunchKernelGGL(yoco_fwd, dim3(grid), dim3(NWAVES * 64), LDS_BYTES, stream, a); }
#else
    a.ph_lo = 0; a.ph_hi = NPHASE;
    hipLaunchKernelGGL(yoco_fwd, dim3(grid), dim3(NWAVES * 64), LDS_BYTES, stream, a);
#endif
    const hipError_t le = hipPeekAtLastError();
    if (le != hipSuccess) fprintf(stderr, "kernel_launch: launch failed: %s\n", hipGetErrorName(le));
}
```

```cpp
#include <hip/hip_runtime.h>
#include <hip/hip_bf16.h>
#include <cstdio>
#include <cstdint>

#define LAS __attribute__((address_space(3)))
#define GAS __attribute__((address_space(1)))

#ifndef FP8_WO
#define FP8_WO true
#endif
constexpr int DM = 2048, NB = 4, SEQ = 2048, T = NB * SEQ, NH = 16, HD = 128;
constexpr int DFF = 5632, NE = 8, DFE = 7168, PLE = 256;
constexpr float RMS_EPS = 1e-6f;
constexpr int MAXRT = 72;
constexpr int MAXROWS = MAXRT * 256;

namespace pg8 {
typedef unsigned short bf16_t;
typedef short bf16x8 __attribute__((ext_vector_type(8)));
typedef float f32x4 __attribute__((ext_vector_type(4)));
typedef unsigned u32x4 __attribute__((ext_vector_type(4)));
constexpr int BM = 256, BK = 64, HALF = 128, HTB = HALF * BK * 2, STAGE_BYTES = 8 * HTB, NXCD = 8, WGM = 4;

__host__ __device__ __forceinline__ int lds_byte(int r, int c) { const int st = (r >> 4) * 2 + (c >> 5), rr = r & 15, cc = c & 31, ob = rr * 64 + cc * 2; return st * 1024 + (ob ^ (((ob >> 9) & 1) << 5)); }
__host__ __device__ __forceinline__ void stage_rc(int b, int& R, int& C) { const int st = b / 1024, sb = b % 1024, swz = sb ^ (((sb >> 9) & 1) << 5); R = (st >> 1) * 16 + swz / 64; C = (st & 1) * 32 + (swz % 64) / 2; }
__host__ __device__ __forceinline__ int perm32(int rho) { const int n = rho >> 4, i = rho & 15; return 8 * (i >> 2) + 4 * n + (i & 3); }

struct Unit { int pm, pn, aux, par; };
struct Gemm { const bf16_t* A; const bf16_t* Bt; int M, N, K; int Kp = 0; };

struct RsNone { __device__ __forceinline__ void fill(const Unit&) const {} };
struct RsDirect { const float* src; LAS float* tab;
    __device__ __forceinline__ void fill(const Unit& u) const { int t = threadIdx.x; asm volatile("" : "+v"(t));
        if (t < 256) tab[u.par * 256 + t] = src[(size_t)u.pm * 256 + t]; } };
struct RsSlots { const float* slots; LAS float* tab; float mul;
    __device__ __forceinline__ void fill(const Unit& u) const {
        int t = threadIdx.x; asm volatile("" : "+v"(t));
        const int row = t >> 1, hf = t & 1; const f32x4* p = (const f32x4*)(slots + ((size_t)u.pm * 256 + row) * 32 + hf * 16);
        const f32x4 a = p[0], b = p[1], c = p[2], d = p[3];
        float s = ((a[0] + a[1]) + (a[2] + a[3])) + ((b[0] + b[1]) + (b[2] + b[3])) + ((c[0] + c[1]) + (c[2] + c[3])) + ((d[0] + d[1]) + (d[2] + d[3]));
        s += __shfl_xor(s, 1);
        if (hf == 0) tab[u.par * 256 + row] = mul / sqrtf(s * (1.0f / DM) + RMS_EPS);
    } };

template <class RS> struct StaticOrder {
    int nM, nN, nwg, G, c, i0, iend; RS rs;
    __device__ __forceinline__ void init(int M, int N, int G_, int c_) { nM = M / BM; nN = N / BM; nwg = nM * nN; G = G_; c = c_; i0 = 0; iend = 1 << 24; }
    __device__ __forceinline__ bool next(int i, Unit& u) const {
        if (i + i0 >= iend) return false;
        const long L = (long)(i + i0) * G + c; if (L >= nwg) return false;
        int wgid = (int)L; { const int q = nwg / NXCD, r = nwg % NXCD, xcd = wgid % NXCD, off = wgid / NXCD; wgid = (xcd < r ? xcd * (q + 1) : r * (q + 1) + (xcd - r) * q) + off; }
        const int nig = WGM * nN, gid = wgid / nig, fm = gid * WGM, gsz = (nM - fm) < WGM ? (nM - fm) : WGM;
        u.pm = fm + ((wgid % nig) % gsz); u.pn = (wgid % nig) / gsz; u.aux = u.pn; u.par = i & 1; return true;
    }
    __device__ __forceinline__ void a_ready(const Unit& u) const { rs.fill(u); }
    __device__ __forceinline__ void done(const Unit&) const {}
};
template <class RS, bool PNFAST = false> struct GroupedOrder {
    int rt[NE]; int NT, G, c, nwg, nlim, i0 = 0, iend = 1 << 24; RS rs;
    __device__ __forceinline__ void init(const int* rts, int NT_, int G_, int c_) { int s = 0;
#pragma unroll
        for (int e = 0; e < NE; ++e) { rt[e] = rts[e]; s += rts[e]; } NT = NT_; G = G_; c = c_; nwg = s * NT_; nlim = nwg; }
    __device__ __forceinline__ void decode(int L, Unit& u) const {
        int wgid = L; { const int q = nwg / NXCD, r = nwg % NXCD, xcd = wgid % NXCD, off = wgid / NXCD; wgid = (xcd < r ? xcd * (q + 1) : r * (q + 1) + (xcd - r) * q) + off; }
        int e = 0, rbase = 0, w = wgid;
#pragma unroll
        for (int k = 0; k < NE - 1; ++k) { const int sz = rt[k] * NT; if (e == k && w >= sz) { w -= sz; rbase += rt[k]; e = k + 1; } }
        int rte = rt[0];
#pragma unroll
        for (int k = 1; k < NE; ++k) rte = (e == k) ? rt[k] : rte;
        int pn, rl; if (PNFAST) { rl = w / NT; pn = w - rl * NT; } else { pn = w / rte; rl = w - pn * rte; }
        u.pm = rbase + rl; u.pn = e * NT + pn; u.aux = pn;
    }
    __device__ __forceinline__ bool next(int i, Unit& u) const {
        if (i + i0 >= iend) return false;
        const long L = (long)(i + i0) * G + c; if (L >= nlim) return false;
        decode((int)L, u); u.par = i & 1; return true;
    }
    __device__ __forceinline__ void a_ready(const Unit& u) const { rs.fill(u); }
    __device__ __forceinline__ void done(const Unit&) const {}
};

struct OneUnit { Unit u;
    __device__ __forceinline__ bool next(int i, Unit& o) const { if (i != 0) return false; o = u; return true; }
    __device__ __forceinline__ void a_ready(const Unit&) const {}
    __device__ __forceinline__ void done(const Unit&) const {}
};
struct PanelOrder { int x, r, W, rtl;
    __device__ __forceinline__ bool next(int i, Unit& u) const { const int j = i * W + r; if (j >= 64) return false;
        const int layer = j >> 5, t4 = (j >> 3) & 3, c8 = j & 7; u.pm = layer * rtl + 4 * x + t4; u.pn = layer * 8 + c8; u.aux = c8; u.par = i & 1; return true; }
    __device__ __forceinline__ void a_ready(const Unit&) const {}
    __device__ __forceinline__ void done(const Unit&) const {}
};

__device__ __forceinline__ unsigned cvt_pk_bf16(float lo, float hi) { unsigned r; asm volatile("v_cvt_pk_bf16_f32 %0, %1, %2" : "=v"(r) : "v"(lo), "v"(hi)); return r; }
__device__ __forceinline__ u32x4 pack8(const f32x4 a, const f32x4 b) { u32x4 w; w.x = cvt_pk_bf16(a[0], a[1]); w.y = cvt_pk_bf16(a[2], a[3]); w.z = cvt_pk_bf16(b[0], b[1]); w.w = cvt_pk_bf16(b[2], b[3]); return w; }
typedef int i32x4 __attribute__((ext_vector_type(4)));
typedef int i32x8 __attribute__((ext_vector_type(8)));
__device__ __forceinline__ i32x8 cat16(const bf16x8 a, const bf16x8 b) { const i32x4 x = __builtin_bit_cast(i32x4, a), y = __builtin_bit_cast(i32x4, b); return __builtin_shufflevector(x, y, 0, 1, 2, 3, 4, 5, 6, 7); }
__device__ __forceinline__ void mfma_f8(f32x4& acc, const i32x8 b, const i32x8 a) { asm volatile("v_mfma_f32_16x16x128_f8f6f4 %0, %1, %2, %0" : "+v"(acc) : "v"(b), "v"(a)); }
__device__ __forceinline__ float clamp8(float v) { return __builtin_amdgcn_fmed3f(v, -448.0f, 448.0f); }
__device__ __forceinline__ unsigned pk4_fp8(float a, float b, float c, float d) { int w = 0; w = __builtin_amdgcn_cvt_pk_fp8_f32(clamp8(a), clamp8(b), w, false); w = __builtin_amdgcn_cvt_pk_fp8_f32(clamp8(c), clamp8(d), w, true); return (unsigned)w; }
__device__ __forceinline__ float bf_lo(unsigned w) { return __uint_as_float(w << 16); }
__device__ __forceinline__ float bf_hi(unsigned w) { return __uint_as_float(w & 0xffff0000u); }
__device__ __forceinline__ float sigmoidf_(float z) { return __builtin_amdgcn_rcpf(1.0f + __builtin_amdgcn_exp2f(-1.4426950408889634f * z)); }


template <bool SCALE> struct EpiBf16S {
    static constexpr bool PERM = true, AFTER_DRAIN = false;
    bf16_t* O; int ldc; int split_cols; size_t split_stride; const LAS float* tab; float cs;
    __device__ __forceinline__ void operator()(const f32x4 (&acc)[2][2][4][2], const Unit& u, int wr, int wc, int fr, int fq) const {
        int colt = u.aux * BM; bf16_t* base = O;
        if (split_cols) { const int t = colt / split_cols; base += (size_t)t * split_stride; colt -= t * split_cols; }
        const int col0 = colt + wc * 32 + 8 * fq;
#pragma unroll
        for (int ai = 0; ai < 2; ++ai)
#pragma unroll
            for (int m = 0; m < 4; ++m) { const int r = ai * HALF + wr * 64 + m * 16 + fr; const float s = SCALE ? tab[u.par * 256 + r] : cs;
                bf16_t* rowp = base + (size_t)(u.pm * BM + r) * ldc + col0;
#pragma unroll
                for (int bj = 0; bj < 2; ++bj) *(u32x4*)(rowp + bj * HALF) = pack8(acc[ai][bj][m][0] * s, acc[ai][bj][m][1] * s); }
    }
};
struct EpiSlab {
    static constexpr bool PERM = true, AFTER_DRAIN = false;
    bf16_t* O; float cs;
    __device__ __forceinline__ void operator()(const f32x4 (&acc)[2][2][4][2], const Unit&, int wr, int wc, int fr, int fq) const {
#pragma unroll
        for (int ai = 0; ai < 2; ++ai)
#pragma unroll
            for (int m = 0; m < 4; ++m) { const int r = ai * HALF + wr * 64 + m * 16 + fr;
#pragma unroll
                for (int bj = 0; bj < 2; ++bj) *(u32x4*)(O + r * BM + bj * HALF + wc * 32 + 8 * fq) = pack8(acc[ai][bj][m][0] * cs, acc[ai][bj][m][1] * cs); }
    }
};
struct EpiQKV {
    static constexpr bool PERM = true, AFTER_DRAIN = false;
    bf16_t* Q; bf16_t* K; bf16_t* V; const float* qg; const float* kg; const LAS float* tab; LAS float* red;
    __device__ __forceinline__ void operator()(const f32x4 (&acc)[2][2][4][2], const Unit& u, int wr, int wc, int fr, int fq) const {
        const int which = u.aux >> 3, pnl = u.aux & 7, dcol = wc * 32 + 8 * fq;
        f32x4 g0 = {1.f, 1.f, 1.f, 1.f}, g1 = {1.f, 1.f, 1.f, 1.f};
        if (which < 2) {
            const float* gp = (which == 0 ? qg : kg) + dcol; g0 = *(const f32x4*)gp; g1 = *(const f32x4*)(gp + 4);
#pragma unroll
            for (int ai = 0; ai < 2; ++ai)
#pragma unroll
                for (int m = 0; m < 4; ++m) { const int r = ai * HALF + wr * 64 + m * 16 + fr; const float s = tab[u.par * 256 + r];
#pragma unroll
                    for (int bj = 0; bj < 2; ++bj) { const f32x4 a = acc[ai][bj][m][0] * s, b = acc[ai][bj][m][1] * s;
                        float p = (a[0] * a[0] + a[1] * a[1]) + (a[2] * a[2] + a[3] * a[3]) + (b[0] * b[0] + b[1] * b[1]) + (b[2] * b[2] + b[3] * b[3]);
                        p += __shfl_xor(p, 16); p += __shfl_xor(p, 32);
                        if (fq == 0) red[r * 8 + bj * 4 + wc] = p; } }
            asm volatile("s_waitcnt lgkmcnt(0)" ::: "memory"); __builtin_amdgcn_s_barrier(); asm volatile("" ::: "memory");
        }
#pragma unroll
        for (int ai = 0; ai < 2; ++ai)
#pragma unroll
            for (int m = 0; m < 4; ++m) { const int r = ai * HALF + wr * 64 + m * 16 + fr; const int t = u.pm * BM + r; const float s = tab[u.par * 256 + r];
#pragma unroll
                for (int bj = 0; bj < 2; ++bj) { const int h = 2 * pnl + bj; float f = s;
                    if (which < 2) { const f32x4 q = *(const LAS f32x4*)(red + r * 8 + bj * 4); f *= 1.0f / sqrtf(((q[0] + q[1]) + (q[2] + q[3])) * (1.0f / HD) + RMS_EPS); }
                    const u32x4 w = pack8(acc[ai][bj][m][0] * f * g0, acc[ai][bj][m][1] * f * g1);
                    if (which == 0) *(u32x4*)(Q + (size_t)t * DM + h * HD + dcol) = w;
                    else { const int b = t / SEQ, sq = t - b * SEQ; *(u32x4*)((which == 1 ? K : V) + ((size_t)(b * NH + h) * SEQ + sq) * HD + dcol) = w; } } }
    }
};
template <int MODE, bool HASPLAIN, bool OUT8 = false, bool ROWTAB = true> struct EpiPair {
    static constexpr bool PERM = true, AFTER_DRAIN = false;
    bf16_t* O; int ldc; int npair; bf16_t* O2; int ldc2; const LAS float* tab; float oscale; float cscale;
    __device__ __forceinline__ void operator()(const f32x4 (&acc)[2][2][4][2], const Unit& u, int wr, int wc, int fr, int fq) const {
        if (!HASPLAIN || u.aux < npair) {
            const int col0 = u.aux * HALF + wc * 32 + 8 * fq;
#pragma unroll
            for (int ai = 0; ai < 2; ++ai)
#pragma unroll
                for (int m = 0; m < 4; ++m) { const int r = ai * HALF + wr * 64 + m * 16 + fr; const float s = ROWTAB ? tab[u.par * 256 + r] : cscale;
                    f32x4 o[2];
#pragma unroll
                    for (int n = 0; n < 2; ++n) { const f32x4 a = acc[ai][0][m][n] * s, b = acc[ai][1][m][n] * s;
                        if (MODE == 0) o[n] = a * b;
                        else {
#pragma unroll
                            for (int j = 0; j < 4; ++j) o[n][j] = a[j] * sigmoidf_(a[j]) * b[j]; } }
                    if constexpr (OUT8) { typedef unsigned u32x2 __attribute__((ext_vector_type(2))); u32x2 w; o[0] *= oscale; o[1] *= oscale;
                        w.x = pk4_fp8(o[0][0], o[0][1], o[0][2], o[0][3]); w.y = pk4_fp8(o[1][0], o[1][1], o[1][2], o[1][3]);
                        *(u32x2*)((unsigned char*)O + (size_t)(u.pm * BM + r) * ldc + col0) = w; }
                    else *(u32x4*)(O + (size_t)(u.pm * BM + r) * ldc + col0) = pack8(o[0], o[1]); }
        } else if (HASPLAIN) {
            const int col0 = (u.aux - npair) * BM + wc * 32 + 8 * fq;
#pragma unroll
            for (int ai = 0; ai < 2; ++ai)
#pragma unroll
                for (int m = 0; m < 4; ++m) { const int r = ai * HALF + wr * 64 + m * 16 + fr; const float s = tab[u.par * 256 + r];
                    bf16_t* rowp = O2 + (size_t)(u.pm * BM + r) * ldc2 + col0;
#pragma unroll
                    for (int bj = 0; bj < 2; ++bj) *(u32x4*)(rowp + bj * HALF) = pack8(acc[ai][bj][m][0] * s, acc[ai][bj][m][1] * s); }
        }
    }
};
template <int MODE, bool HIN_F32, bool OUT_F32, bool CSCALE = false> struct EpiResid {
    static constexpr bool PERM = true, AFTER_DRAIN = false;
    const void* hin; void* hout; float* slots; const bf16_t* E; const LAS float* tab; unsigned char* h8; float h8scale; float ascale;
    __device__ __forceinline__ void operator()(const f32x4 (&acc)[2][2][4][2], const Unit& u, int wr, int wc, int fr, int fq) const {
        const int col0 = u.aux * BM + wc * 32 + 8 * fq;
        constexpr int MB = (MODE == 0 && HIN_F32) ? 2 : 4;
#pragma unroll
        for (int ai = 0; ai < 2; ++ai)
#pragma unroll
            for (int m0 = 0; m0 < 4; m0 += MB) {
                f32x4 pre[MB][2][2]; u32x4 pb[MB][2], pe[MB][2];
#pragma unroll
                for (int mm = 0; mm < MB; ++mm) { const int r = ai * HALF + wr * 64 + (m0 + mm) * 16 + fr; const size_t off = (size_t)(u.pm * BM + r) * DM + col0;
#pragma unroll
                    for (int bj = 0; bj < 2; ++bj) {
                        if (HIN_F32) { pre[mm][bj][0] = *(const f32x4*)((const float*)hin + off + bj * HALF); pre[mm][bj][1] = *(const f32x4*)((const float*)hin + off + bj * HALF + 4); }
                        else pb[mm][bj] = *(const u32x4*)((const bf16_t*)hin + off + bj * HALF);
                        if (MODE == 1) pe[mm][bj] = *(const u32x4*)(E + off + bj * HALF); } }
#pragma unroll
                for (int mm = 0; mm < MB; ++mm) { const int m = m0 + mm; const int r = ai * HALF + wr * 64 + m * 16 + fr; const size_t off = (size_t)(u.pm * BM + r) * DM + col0;
                    float s = 1.0f; if (MODE == 1) s = CSCALE ? ascale : tab[u.par * 256 + r];
                    float ss = 0.f;
#pragma unroll
                    for (int bj = 0; bj < 2; ++bj) {
                        f32x4 v0, v1;
                        if (HIN_F32) { v0 = pre[mm][bj][0]; v1 = pre[mm][bj][1]; }
                        else { const u32x4 h = pb[mm][bj]; v0 = (f32x4){bf_lo(h.x), bf_hi(h.x), bf_lo(h.y), bf_hi(h.y)}; v1 = (f32x4){bf_lo(h.z), bf_hi(h.z), bf_lo(h.w), bf_hi(h.w)}; }
                        if (MODE == 0) { v0 += acc[ai][bj][m][0] * ascale; v1 += acc[ai][bj][m][1] * ascale; }
                        else { const u32x4 e = pe[mm][bj]; const f32x4 a0 = acc[ai][bj][m][0] * s, a1 = acc[ai][bj][m][1] * s;
                            v0[0] += sigmoidf_(a0[0]) * bf_lo(e.x); v0[1] += sigmoidf_(a0[1]) * bf_hi(e.x); v0[2] += sigmoidf_(a0[2]) * bf_lo(e.y); v0[3] += sigmoidf_(a0[3]) * bf_hi(e.y);
                            v1[0] += sigmoidf_(a1[0]) * bf_lo(e.z); v1[1] += sigmoidf_(a1[1]) * bf_hi(e.z); v1[2] += sigmoidf_(a1[2]) * bf_lo(e.w); v1[3] += sigmoidf_(a1[3]) * bf_hi(e.w); }
                        if (OUT_F32) { *(f32x4*)((float*)hout + off + bj * HALF) = v0; *(f32x4*)((float*)hout + off + bj * HALF + 4) = v1; }
                        else *(u32x4*)((bf16_t*)hout + off + bj * HALF) = pack8(v0, v1);
                        if (h8) { typedef unsigned u32x2 __attribute__((ext_vector_type(2))); u32x2 w; w.x = pk4_fp8(v0[0] * h8scale, v0[1] * h8scale, v0[2] * h8scale, v0[3] * h8scale); w.y = pk4_fp8(v1[0] * h8scale, v1[1] * h8scale, v1[2] * h8scale, v1[3] * h8scale); *(u32x2*)(h8 + off + bj * HALF) = w; }
                        ss += (v0[0] * v0[0] + v0[1] * v0[1]) + (v0[2] * v0[2] + v0[3] * v0[3]) + (v1[0] * v1[0] + v1[1] * v1[1]) + (v1[2] * v1[2] + v1[3] * v1[3]);
                    }
                    if (slots) { ss += __shfl_xor(ss, 16); ss += __shfl_xor(ss, 32); if (fq == 0) slots[(size_t)(u.pm * BM + r) * 32 + u.aux * 4 + wc] = ss; }
                }
                asm volatile("" ::: "memory");
            }
    }
};
struct EpiF32S {
    static constexpr bool PERM = true, AFTER_DRAIN = false;
    float* O; int ldc; const LAS float* tab;
    __device__ __forceinline__ void operator()(const f32x4 (&acc)[2][2][4][2], const Unit& u, int wr, int wc, int fr, int fq) const {
        const int col0 = u.aux * BM + wc * 32 + 8 * fq;
#pragma unroll
        for (int ai = 0; ai < 2; ++ai)
#pragma unroll
            for (int m = 0; m < 4; ++m) { const int r = ai * HALF + wr * 64 + m * 16 + fr; const float s = tab[u.par * 256 + r];
                float* rowp = O + (size_t)(u.pm * BM + r) * ldc + col0;
#pragma unroll
                for (int bj = 0; bj < 2; ++bj) { *(f32x4*)(rowp + bj * HALF) = acc[ai][bj][m][0] * s; *(f32x4*)(rowp + bj * HALF + 4) = acc[ai][bj][m][1] * s; } }
    }
};

template <class Epi, class Sched, bool ALIGN_EPI = false, bool SP2 = false, bool FP8 = false>
__device__ __forceinline__ void gemm_phase(LAS unsigned char* lds, const Gemm g, const Sched& S, const Epi& E) {
    int tid = threadIdx.x; asm volatile("" : "+v"(tid));
    const int wid = __builtin_amdgcn_readfirstlane(tid >> 6), lane = tid & 63, wr = wid >> 2, wc = wid & 3, fr = lane & 15, fq = lane >> 4;
    int Kx = g.K; asm volatile("" : "+s"(Kx));
    const int nt = Kx / BK; const int K = g.Kp ? g.Kp : Kx;
    unsigned voffA[2], voffB[2];
#pragma unroll
    for (int i = 0; i < 2; ++i) { int R, C; stage_rc(tid * 16 + i * 8192, R, C); const int Rb = Epi::PERM ? ((R & ~31) + perm32(R & 31)) : R;
        voffA[i] = (unsigned)(R * K + C) * 2u; voffB[i] = (unsigned)(Rb * K + C) * 2u; }
    const size_t kstep = (size_t)(BK * 2);
    const size_t hstep = (size_t)HALF * K * 2;
    const size_t tstep = 2 * hstep;
    const unsigned ldsw = (unsigned)wid * 1024u;
    const int aoff = lds_byte(wr * 64 + fr, fq * 8), boff = lds_byte(wc * 32 + fr, fq * 8);
#define PG8_SA(b, h) (((b) * 2 + (h)) * HTB)
#define PG8_SB(b, h) ((4 + (b) * 2 + (h)) * HTB)
#define PG8_STAGE(bufoff, gbase, voff) do { _Pragma("unroll") for (int _i = 0; _i < 2; ++_i) \
        __builtin_amdgcn_global_load_lds((const unsigned*)((const char*)(gbase) + (voff)[_i]), (LAS unsigned*)(lds + (bufoff) + ldsw + _i * 8192), 16, 0, 0); } while (0)
#define PG8_LDA(dst, b, h) do { _Pragma("unroll") for (int m = 0; m < 4; ++m) _Pragma("unroll") for (int k = 0; k < 2; ++k) dst[m][k] = *(const LAS bf16x8*)(lds + PG8_SA(b, h) + aoff + m * 2048 + k * 1024); } while (0)
#define PG8_LDB(dst, b, h) do { _Pragma("unroll") for (int n = 0; n < 2; ++n) _Pragma("unroll") for (int k = 0; k < 2; ++k) dst[n][k] = *(const LAS bf16x8*)(lds + PG8_SB(b, h) + boff + n * 2048 + k * 1024); } while (0)
#define PG8_MMA(ai, bj, At, Bt) do { __builtin_amdgcn_s_setprio(1); _Pragma("unroll") for (int m = 0; m < 4; ++m) _Pragma("unroll") for (int n = 0; n < 2; ++n) { \
        if constexpr (FP8) mfma_f8(acc[ai][bj][m][n], cat16(Bt[n][0], Bt[n][1]), cat16(At[m][0], At[m][1])); \
        else { _Pragma("unroll") for (int k = 0; k < 2; ++k) acc[ai][bj][m][n] = __builtin_amdgcn_mfma_f32_16x16x32_bf16(Bt[n][k], At[m][k], acc[ai][bj][m][n], 0, 0, 0); } } \
        __builtin_amdgcn_s_setprio(0); } while (0)
#define PG8_WAIT_V(n) asm volatile("s_waitcnt vmcnt(" #n ")" ::: "memory")
#define PG8_WAIT_L(n) asm volatile("s_waitcnt lgkmcnt(" #n ")" ::: "memory")
#define PG8_BAR __builtin_amdgcn_s_barrier()
#define PG8_SCHED __builtin_amdgcn_sched_barrier(0)
    Unit cur, nxt; int ui = 0;
    if (!S.next(0, cur)) return;
    f32x4 acc[2][2][4][2];
#pragma unroll
    for (int a = 0; a < 2; ++a)
#pragma unroll
        for (int b = 0; b < 2; ++b)
#pragma unroll
            for (int m = 0; m < 4; ++m)
#pragma unroll
                for (int n = 0; n < 2; ++n) acc[a][b][m][n] = (f32x4){0.f, 0.f, 0.f, 0.f};
    bf16x8 At[4][2], B0[2][2], B1[2][2];
    const char* cA = (const char*)g.A + (size_t)cur.pm * tstep; const char* cB = (const char*)g.Bt + (size_t)cur.pn * tstep;
    S.a_ready(cur);
    if constexpr (SP2) {
        PG8_STAGE(PG8_SB(0, 0), cB, voffB); PG8_STAGE(PG8_SB(0, 1), cB + hstep, voffB); PG8_STAGE(PG8_SA(0, 0), cA, voffA); PG8_STAGE(PG8_SA(0, 1), cA + hstep, voffA);
        if (wr == 1) PG8_BAR;
        PG8_WAIT_V(2); PG8_BAR;
        PG8_STAGE(PG8_SB(1, 0), cB + kstep, voffB); PG8_STAGE(PG8_SA(1, 0), cA + kstep, voffA); PG8_STAGE(PG8_SB(1, 1), cB + hstep + kstep, voffB);
        PG8_WAIT_V(6); PG8_BAR;
    } else {
        PG8_STAGE(PG8_SB(0, 0), cB, voffB); PG8_STAGE(PG8_SA(0, 0), cA, voffA); PG8_STAGE(PG8_SB(0, 1), cB + hstep, voffB); PG8_STAGE(PG8_SA(0, 1), cA + hstep, voffA);
        if (wr == 1) PG8_BAR;
        PG8_WAIT_V(4); PG8_BAR;
        PG8_STAGE(PG8_SB(1, 0), cB + kstep, voffB); PG8_STAGE(PG8_SA(1, 0), cA + kstep, voffA); PG8_STAGE(PG8_SB(1, 1), cB + hstep + kstep, voffB);
        PG8_WAIT_V(6); PG8_BAR;
    }
    for (;;) {
        const bool has_next = S.next(ui + 1, nxt);
        const char* nA = has_next ? (const char*)g.A + (size_t)nxt.pm * tstep : cA; const char* nB = has_next ? (const char*)g.Bt + (size_t)nxt.pn * tstep : cB;
        for (int t = 0; t < nt; t += 2) {
            const bool last = (t == nt - 2);
            const char* a1 = cA + (size_t)(t + 1) * kstep;
            const char* a2 = last ? nA : cA + (size_t)(t + 2) * kstep; const char* b2 = last ? nB : cB + (size_t)(t + 2) * kstep;
            const char* a3 = a2 + kstep; const char* b3 = b2 + kstep;
            if (last && has_next) S.a_ready(nxt);
            if constexpr (SP2) {
            PG8_LDB(B0, 0, 0); PG8_LDB(B1, 0, 1); PG8_SCHED; PG8_LDA(At, 0, 0); PG8_STAGE(PG8_SA(1, 1), a1 + hstep, voffA);
            PG8_WAIT_V(8); PG8_WAIT_L(0); PG8_BAR; PG8_MMA(0, 0, At, B0); PG8_MMA(0, 1, At, B1); PG8_BAR; PG8_SCHED;
            PG8_LDA(At, 0, 1); PG8_STAGE(PG8_SB(0, 0), b2, voffB); PG8_STAGE(PG8_SB(0, 1), b2 + hstep, voffB); PG8_STAGE(PG8_SA(0, 0), a2, voffA);
            PG8_WAIT_V(8); PG8_WAIT_L(0); PG8_BAR; PG8_MMA(1, 0, At, B0); PG8_MMA(1, 1, At, B1); PG8_BAR; PG8_SCHED;
            PG8_LDB(B0, 1, 0); PG8_LDB(B1, 1, 1); PG8_SCHED; PG8_LDA(At, 1, 0); PG8_STAGE(PG8_SA(0, 1), a2 + hstep, voffA);
            PG8_WAIT_V(8); PG8_WAIT_L(0); PG8_BAR; PG8_MMA(0, 0, At, B0); PG8_MMA(0, 1, At, B1); PG8_BAR; PG8_SCHED;
            PG8_LDA(At, 1, 1); PG8_STAGE(PG8_SB(1, 0), b3, voffB); PG8_STAGE(PG8_SB(1, 1), b3 + hstep, voffB); PG8_STAGE(PG8_SA(1, 0), a3, voffA);
            PG8_WAIT_V(8); PG8_WAIT_L(0); PG8_BAR; PG8_MMA(1, 0, At, B0); PG8_MMA(1, 1, At, B1); PG8_BAR; PG8_SCHED;
            } else {
            PG8_LDB(B0, 0, 0); PG8_SCHED; PG8_LDA(At, 0, 0); PG8_STAGE(PG8_SA(1, 1), a1 + hstep, voffA);
            PG8_WAIT_L(8); PG8_BAR; PG8_WAIT_L(0); PG8_MMA(0, 0, At, B0); PG8_BAR; PG8_SCHED;
            PG8_LDB(B1, 0, 1); PG8_STAGE(PG8_SB(0, 0), b2, voffB);
            PG8_BAR; PG8_WAIT_L(0); PG8_MMA(0, 1, At, B1); PG8_BAR;
            PG8_LDA(At, 0, 1); PG8_STAGE(PG8_SA(0, 0), a2, voffA);
            PG8_BAR; PG8_WAIT_L(0); PG8_MMA(1, 0, At, B0); PG8_BAR; PG8_SCHED;
            PG8_STAGE(PG8_SB(0, 1), b2 + hstep, voffB);
            PG8_WAIT_V(6); PG8_BAR; PG8_MMA(1, 1, At, B1); PG8_BAR;
            PG8_LDB(B0, 1, 0); PG8_SCHED; PG8_LDA(At, 1, 0); PG8_STAGE(PG8_SA(0, 1), a2 + hstep, voffA);
            PG8_WAIT_L(8); PG8_BAR; PG8_WAIT_L(0); PG8_MMA(0, 0, At, B0); PG8_BAR; PG8_SCHED;
            PG8_LDB(B1, 1, 1); PG8_STAGE(PG8_SB(1, 0), b3, voffB);
            PG8_BAR; PG8_WAIT_L(0); PG8_MMA(0, 1, At, B1); PG8_BAR;
            PG8_LDA(At, 1, 1); PG8_STAGE(PG8_SA(1, 0), a3, voffA);
            PG8_BAR; PG8_WAIT_L(0); PG8_MMA(1, 0, At, B0); PG8_BAR; PG8_SCHED;
            PG8_STAGE(PG8_SB(1, 1), b3 + hstep, voffB);
            PG8_WAIT_V(6); PG8_BAR; PG8_MMA(1, 1, At, B1); PG8_BAR;
            }
        }
        if constexpr (ALIGN_EPI) { if (wr == 0) PG8_BAR; }
        if constexpr (FP8) { asm volatile("s_nop 15\n\ts_nop 15" ::: "memory"); PG8_SCHED; }
        if constexpr (!Epi::AFTER_DRAIN) { E(acc, cur, wr, wc, fr, fq); S.done(cur); }
        if (!has_next) break;
#pragma unroll
        for (int a = 0; a < 2; ++a)
#pragma unroll
            for (int b = 0; b < 2; ++b)
#pragma unroll
                for (int m = 0; m < 4; ++m)
#pragma unroll
                    for (int n = 0; n < 2; ++n) acc[a][b][m][n] = (f32x4){0.f, 0.f, 0.f, 0.f};
        cur = nxt; cA = nA; cB = nB; ++ui;
        if constexpr (ALIGN_EPI) { if (wr == 1) PG8_BAR; }
    }
    PG8_WAIT_V(0);
    if constexpr (!ALIGN_EPI) { if (wr == 0) PG8_BAR; }
    PG8_BAR;
#undef PG8_SA
#undef PG8_SB
#undef PG8_STAGE
#undef PG8_LDA
#undef PG8_LDB
#undef PG8_MMA
#undef PG8_WAIT_V
#undef PG8_WAIT_L
#undef PG8_BAR
#undef PG8_SCHED
}
}

namespace fox {
using bf16 = __hip_bfloat16;
typedef short bf16x8 __attribute__((ext_vector_type(8)));
typedef short s16x4 __attribute__((ext_vector_type(4)));
typedef float f32x16 __attribute__((ext_vector_type(16)));
typedef float f32x4 __attribute__((ext_vector_type(4)));
typedef unsigned u32x4 __attribute__((ext_vector_type(4)));
constexpr int D = 128, LD = DM, LDKV = 128;
constexpr float SCALE = 0.08838834764831845f;
constexpr float THR = 8.f;
constexpr int NW = 8, QBLK = 32, KVBLK = 64, QB = NW * QBLK;
constexpr int SHM_V = KVBLK * D * 2, SHM_K = KVBLK * D * 2;
constexpr int CB_OFF = 2 * SHM_V + 2 * SHM_K + NW * 64 * 4;
constexpr int QS_OFF = CB_OFF + 2 * SEQ * 4;
constexpr int WSUM_OFF = QS_OFF + NW * 8192;
constexpr int LDS_BYTES = WSUM_OFF + 64;

#define KSWZ(row, colB) ((row) * 256 + ((colB) ^ (((row) & 7) << 4)))
#define SBAR() __builtin_amdgcn_sched_barrier(0)
__device__ __forceinline__ int v_st(int k, int c) { const int kk = (k & ~0xC) | ((k & 4) << 1) | ((k & 8) >> 1); return ((kk >> 3) * 4 + (c >> 5)) * 512 + ((kk & 7) * 32 + (c & 31)) * 2; }
__device__ __forceinline__ int v_rd_base(int lane) { return ((lane & 3) << 3) | (((lane >> 2) & 3) << 6) | (((lane >> 4) & 1) << 5) | (((lane >> 5) & 1) << 8); }
constexpr int v_rd_off(int d0, int ks, int half) { return d0 * 512 + ks * 4096 + half * 2048; }
__device__ __forceinline__ int crow(int r, int hi) { return (r & 3) + 8 * (r >> 2) + 4 * hi; }
__device__ __forceinline__ unsigned cvtpk(float lo, float hi) { unsigned r; asm volatile("v_cvt_pk_bf16_f32 %0, %1, %2" : "=v"(r) : "v"(lo), "v"(hi)); return r; }
__device__ __forceinline__ bf16x8 load8(const bf16* p) { return *reinterpret_cast<const bf16x8*>(p); }
__device__ __forceinline__ void mask_tile(f32x16& p0, f32x16& p1, int dq) {
    const float NEG = -__builtin_inff();
#pragma unroll
    for (int r = 0; r < 16; ++r) {
        const int c = (r & 3) + 8 * (r >> 2);
        if (dq - c < 0) p0[r] = NEG;
        if (dq - c - 32 < 0) p1[r] = NEG;
    }
}
__device__ __forceinline__ void partialSM(f32x16& p0, f32x16& p1, float& m_reg, float& mn, float& alpha) {
    float pmax = p0[0]; for (int r = 1; r < 16; ++r) pmax = fmaxf(pmax, p0[r]); for (int r = 0; r < 16; ++r) pmax = fmaxf(pmax, p1[r]);
    { auto rr = __builtin_amdgcn_permlane32_swap(__float_as_uint(pmax), __float_as_uint(pmax), false, false);
      pmax = fmaxf(__uint_as_float(rr[0]), __uint_as_float(rr[1])); }
    constexpr float C2 = 1.4426950408889634f * SCALE;
    if (__builtin_expect(__all((pmax - m_reg) * SCALE <= THR), 1)) { mn = m_reg; alpha = 1.f; }
    else { mn = fmaxf(m_reg, pmax); alpha = __builtin_amdgcn_exp2f((m_reg - mn) * C2); m_reg = mn; }
    const float mnL = -mn * C2;
    for (int r = 0; r < 16; ++r) p0[r] = fmaf(p0[r], C2, mnL); for (int r = 0; r < 16; ++r) p1[r] = fmaf(p1[r], C2, mnL);
    for (int r = 0; r < 16; ++r) p0[r] = __builtin_amdgcn_exp2f(p0[r]);
}
__device__ __forceinline__ void finishSM(f32x16& p0, f32x16& p1, float alpha, float& l_reg, bf16x8& pa0, bf16x8& pa1, bf16x8& pa2, bf16x8& pa3) {
    for (int r = 0; r < 16; ++r) p1[r] = __builtin_amdgcn_exp2f(p1[r]);
    float ps = 0; for (int r = 0; r < 16; ++r) ps += p0[r]; for (int r = 0; r < 16; ++r) ps += p1[r];
    { auto rr = __builtin_amdgcn_permlane32_swap(__float_as_uint(ps), __float_as_uint(ps), false, false);
      ps = __uint_as_float(rr[0]) + __uint_as_float(rr[1]); }
    l_reg = l_reg * alpha + ps;
#define PK4(P, B_, OUT) do { unsigned a0 = cvtpk(P[B_+0], P[B_+1]), a1 = cvtpk(P[B_+2], P[B_+3]);                          \
        unsigned b0 = cvtpk(P[B_+4], P[B_+5]), b1 = cvtpk(P[B_+6], P[B_+7]);                                             \
        auto r0 = __builtin_amdgcn_permlane32_swap(a0, b0, false, false); auto r1 = __builtin_amdgcn_permlane32_swap(a1, b1, false, false); \
        u32x4 w = {r0[0], r1[0], r0[1], r1[1]}; OUT = *reinterpret_cast<bf16x8*>(&w); } while (0)
    PK4(p0, 0, pa0); PK4(p0, 8, pa1); PK4(p1, 0, pa2); PK4(p1, 8, pa3);
#undef PK4
}
#ifndef QREG
#define QREG 4
#endif
template <int KB>
__device__ __forceinline__ void qkt(f32x16& p0, f32x16& p1, const char* K_lds, int r32, int hi, const char* qs, const bf16x8* qr, const float* cbt) {
    { const f32x4 a0 = *(const f32x4*)(cbt), a1 = *(const f32x4*)(cbt + 8), a2 = *(const f32x4*)(cbt + 16), a3 = *(const f32x4*)(cbt + 24);
      const f32x4 b0 = *(const f32x4*)(cbt + 32), b1 = *(const f32x4*)(cbt + 40), b2 = *(const f32x4*)(cbt + 48), b3 = *(const f32x4*)(cbt + 56);
      p0 = (f32x16){a0[0], a0[1], a0[2], a0[3], a1[0], a1[1], a1[2], a1[3], a2[0], a2[1], a2[2], a2[3], a3[0], a3[1], a3[2], a3[3]};
      p1 = (f32x16){b0[0], b0[1], b0[2], b0[3], b1[0], b1[1], b1[2], b1[3], b2[0], b2[1], b2[2], b2[3], b3[0], b3[1], b3[2], b3[3]}; }
    const char* kb[4];
#pragma unroll
    for (int dd = 0; dd < 4; ++dd) kb[dd] = K_lds + KB * SHM_K + KSWZ(r32, (dd * 16 + hi * 8) * 2);
#pragma unroll
    for (int d0 = 0; d0 < 8; ++d0) { const char* a = kb[d0 & 3] + (d0 >> 2) * 128;
        bf16x8 b0 = *reinterpret_cast<const bf16x8*>(a);
        bf16x8 b1 = *reinterpret_cast<const bf16x8*>(a + 32 * 256);
        const bf16x8 q = (d0 < QREG) ? qr[d0] : *reinterpret_cast<const bf16x8*>(qs + d0 * 1024);
        p0 = __builtin_amdgcn_mfma_f32_32x32x16_bf16(b0, q, p0, 0, 0, 0);
        p1 = __builtin_amdgcn_mfma_f32_32x32x16_bf16(b1, q, p1, 0, 0, 0); }
}
template <int VB>
__device__ __forceinline__ void pv_tile(f32x16* o, int vb0, bf16x8 pa0, bf16x8 pa1, bf16x8 pa2, bf16x8 pa3) {
#define TRRD(dst, off) asm volatile("ds_read_b64_tr_b16 %0, %1 offset:%2" : "=&v"(dst) : "v"(vb0), "i"(off) : "memory")
#define PV_D0(d0) do { s16x4 l0, l1, l2, l3, h0, h1, h2, h3; constexpr int b_ = VB * SHM_V + v_rd_off(d0, 0, 0); \
        TRRD(l0, b_); TRRD(h0, b_ + 2048); TRRD(l1, b_ + 4096); TRRD(h1, b_ + 6144); TRRD(l2, b_ + 8192); TRRD(h2, b_ + 10240); TRRD(l3, b_ + 12288); TRRD(h3, b_ + 14336); \
        asm volatile("s_waitcnt lgkmcnt(0)" ::: "memory"); SBAR();   \
        o[d0] = __builtin_amdgcn_mfma_f32_32x32x16_bf16(pa0, (bf16x8){l0[0], l0[1], l0[2], l0[3], h0[0], h0[1], h0[2], h0[3]}, o[d0], 0, 0, 0);   \
        o[d0] = __builtin_amdgcn_mfma_f32_32x32x16_bf16(pa1, (bf16x8){l1[0], l1[1], l1[2], l1[3], h1[0], h1[1], h1[2], h1[3]}, o[d0], 0, 0, 0);   \
        o[d0] = __builtin_amdgcn_mfma_f32_32x32x16_bf16(pa2, (bf16x8){l2[0], l2[1], l2[2], l2[3], h2[0], h2[1], h2[2], h2[3]}, o[d0], 0, 0, 0);   \
        o[d0] = __builtin_amdgcn_mfma_f32_32x32x16_bf16(pa3, (bf16x8){l3[0], l3[1], l3[2], l3[3], h3[0], h3[1], h3[2], h3[3]}, o[d0], 0, 0, 0); } while (0)
    PV_D0(0); PV_D0(1); PV_D0(2); PV_D0(3);
#undef PV_D0
#undef TRRD
}
struct Ptrs { const bf16* Q; const bf16* K; const bf16* V; bf16* O; const float* CB; };
struct BlockRef { unsigned qoff, kvoff, cboff; int P0; };
struct Seam { bf16x8 qr[8]; bf16x8 st_v0, st_v1, st_k0, st_k1; };
#define ROW(p, k0, rr) ((p) + (size_t)((k0) + (rr)) * LDKV + sc)
#define VMW() asm volatile("s_waitcnt vmcnt(0)" ::: "memory")
#define VMWN(n) asm volatile("s_waitcnt vmcnt(%0)" :: "i"(n) : "memory")
#define SLOAD_H(Kp, Vp, k0) do { S.st_v0 = load8(ROW(Vp, k0, sr)); S.st_v1 = load8(ROW(Vp, k0, 32 + sr));              \
                         S.st_k0 = load8(ROW(Kp, k0, sr)); S.st_k1 = load8(ROW(Kp, k0, 32 + sr)); } while (0)
#define SWRITE_HK(bf) do { *(bf16x8*)(K_lds + (bf) * SHM_K + kws) = S.st_k0; *(bf16x8*)(K_lds + (bf) * SHM_K + kws + 32 * 256) = S.st_k1; } while (0)
#define SWRITE_HV(bf) do { *(bf16x8*)(V_lds + (bf) * SHM_V + vst0) = S.st_v0; *(bf16x8*)(V_lds + (bf) * SHM_V + vst1) = S.st_v1; } while (0)
#define SWRITE_H(bf) do { SWRITE_HV(bf); SWRITE_HK(bf); } while (0)
__device__ __forceinline__ void load_cb(const Ptrs& P, const BlockRef& b, char* lds, int par) {
    const int tid = threadIdx.x, lane = tid & 63, wid = tid >> 6; float* dst = (float*)(lds + CB_OFF + par * (SEQ * 4)); float* wsum = (float*)(lds + WSUM_OFF);
    const f32x4 v = *(const f32x4*)(P.CB + b.cboff + 4 * tid);
    const float a0 = v[0], a1 = a0 + v[1], a2 = a1 + v[2], a3 = a2 + v[3];
    float incl = a3;
#pragma unroll
    for (int o = 1; o < 64; o <<= 1) { const float t = __shfl_up(incl, o); if (lane >= o) incl += t; }
    if (lane == 63) wsum[wid] = incl;
    __syncthreads();
    float off = incl - a3;
#pragma unroll
    for (int w = 0; w < NW; ++w) off += (w < wid) ? wsum[w] : 0.f;
    const float k = -11.313708498984761f;
    *(f32x4*)(dst + 4 * tid) = (f32x4){(off + a0) * k, (off + a1) * k, (off + a2) * k, (off + a3) * k};
}
__device__ __forceinline__ void fox_prime(const Ptrs& P, const BlockRef& cur, char* lds, Seam& S) {
    const int tid = threadIdx.x, wid = __builtin_amdgcn_readfirstlane(tid >> 6), lane = tid & 63, r32 = lane & 31, hi = lane >> 5;
    const int sr = tid >> 4, sc = (tid & 15) * 8, kws = KSWZ(sr, sc * 2); char* K_lds = lds + 2 * SHM_V;
    for (int d0 = 0; d0 < 8; ++d0) S.qr[d0] = load8(P.Q + cur.qoff + (size_t)(wid * QBLK + r32) * LD + d0 * 16 + hi * 8);
    SLOAD_H(P.K + cur.kvoff, P.V + cur.kvoff, 0); VMW(); SWRITE_HK(0);
    load_cb(P, cur, lds, 0);
    __syncthreads();
}
__device__ __forceinline__ void fox_block(const Ptrs& P, const BlockRef& cur, const BlockRef& nxt, int par, char* lds, Seam& S) {
    const int tid = threadIdx.x, wid = __builtin_amdgcn_readfirstlane(tid >> 6), lane = tid & 63, r32 = lane & 31, hi = lane >> 5;
    const int NT = (cur.P0 + QB) / KVBLK;
    const int qlo = cur.P0 + wid * QBLK, qm = qlo + r32 - 4 * hi;
    char* V_lds = lds; char* K_lds = lds + 2 * SHM_V;
    float* ws = (float*)(lds + 2 * SHM_V + 2 * SHM_K) + wid * 64; float* li_l = ws, * al_l = ws + 32;
    const float* cbl = (const float*)(lds + CB_OFF + par * (SEQ * 4)) + 4 * hi;
    float m_reg = -1e30f, l_reg = 0; f32x16 o[4] = {};
    const int sr = tid >> 4, sc = (tid & 15) * 8, vst0 = v_st(sr, sc), vst1 = v_st(32 + sr, sc), kws = KSWZ(sr, sc * 2);
    const int vb0 = (int)(uintptr_t)V_lds + v_rd_base(lane);
    const bf16* Kh = P.K + cur.kvoff; const bf16* Vh = P.V + cur.kvoff;
    char* qs = lds + QS_OFF + wid * 8192 + lane * 16;
#define RESC(a) do { if (__any((a) < 1.f)) { if (hi == 0) al_l[r32] = (a); asm volatile("s_waitcnt lgkmcnt(0)" ::: "memory");              \
                     for (int d_ = 0; d_ < 4; ++d_) for (int r = 0; r < 16; ++r) o[d_][r] *= al_l[crow(r, hi)]; } } while (0)
#define KBASE(t) ((t) * KVBLK)
#define MASKT(P0_, P1_, t) do { const int kb_ = KBASE(t); if (kb_ + KVBLK - 1 > qlo) mask_tile(P0_, P1_, qm - kb_); } while (0)
    constexpr int NQL = 8;
#define SEAM_K0() do { VMWN(NQL); SWRITE_HK(0); SBAR(); } while (0)
    f32x16 pA0, pA1, pB0, pB1; float mnA, mnB, alA, alB; bf16x8 pa0, pa1, pa2, pa3;
    SWRITE_HV(0);
#pragma unroll
    for (int d0 = QREG; d0 < 8; ++d0) *(bf16x8*)(qs + d0 * 1024) = S.qr[d0];
    SBAR();
    if (NT > 1) { SLOAD_H(Kh, Vh, KBASE(1)); }
    SBAR(); qkt<0>(pA0, pA1, K_lds, r32, hi, qs, S.qr, cbl);
    MASKT(pA0, pA1, 0); partialSM(pA0, pA1, m_reg, mnA, alA);
    if (NT > 1) { VMW(); SWRITE_H(1); }
    __syncthreads();
#define HALF_STEP(PX0, PX1, mnX, alX, PY0, PY1, alY, t, KB, VB, SB) do {                                                      \
        SBAR(); qkt<KB>(PX0, PX1, K_lds, r32, hi, qs, S.qr, cbl + (t) * KVBLK);                                                   \
        finishSM(PY0, PY1, alY, l_reg, pa0, pa1, pa2, pa3); SBAR();                                                           \
        if ((t) + 1 < NT) { SLOAD_H(Kh, Vh, KBASE((t) + 1)); SBAR(); }                                                        \
        pv_tile<VB>(o, vb0, pa0, pa1, pa2, pa3); MASKT(PX0, PX1, (t)); partialSM(PX0, PX1, m_reg, mnX, alX);                  \
        __syncthreads();                                                                                                      \
        if ((t) + 1 < NT) { VMW(); SWRITE_H(SB); }                                                                            \
        RESC(alX); __syncthreads(); } while (0)
    for (int t = 1; t + 1 < NT; t += 2) {
        HALF_STEP(pB0, pB1, mnB, alB, pA0, pA1, alA, t, 1, 0, 0);
        HALF_STEP(pA0, pA1, mnA, alA, pB0, pB1, alB, t + 1, 0, 1, 1);
    }
    const bool even = (NT & 1) == 0;
    if (even) { SBAR(); qkt<1>(pB0, pB1, K_lds, r32, hi, qs, S.qr, cbl + (NT - 1) * KVBLK); SBAR(); }
    SLOAD_H(P.K + nxt.kvoff, P.V + nxt.kvoff, 0); SBAR();
#pragma unroll
    for (int d0 = 0; d0 < 8; ++d0) S.qr[d0] = load8(P.Q + nxt.qoff + (size_t)(wid * QBLK + r32) * LD + d0 * 16 + hi * 8);
    SBAR();
    finishSM(pA0, pA1, alA, l_reg, pa0, pa1, pa2, pa3); SBAR();
    pv_tile<0>(o, vb0, pa0, pa1, pa2, pa3);
    if (even) { MASKT(pB0, pB1, NT - 1); partialSM(pB0, pB1, m_reg, mnB, alB); __syncthreads(); RESC(alB);
        finishSM(pB0, pB1, alB, l_reg, pa0, pa1, pa2, pa3); SBAR(); pv_tile<1>(o, vb0, pa0, pa1, pa2, pa3); }
    SBAR(); SEAM_K0();
    if (hi == 0) li_l[r32] = l_reg; asm volatile("s_waitcnt lgkmcnt(0)" ::: "memory");
    float rli[16];
#pragma unroll
    for (int r = 0; r < 16; ++r) rli[r] = __builtin_amdgcn_rcpf(li_l[crow(r, hi)]);
    bf16* Ow = P.O + cur.qoff + (size_t)(wid * QBLK) * LD;
    if (FP8_WO) {
        unsigned char* stg = (unsigned char*)(lds + QS_OFF + wid * 8192);
#pragma unroll
        for (int r = 0; r < 16; ++r) { const int orow = crow(r, hi);
#pragma unroll
            for (int d0 = 0; d0 < 4; ++d0) { float v = o[d0][r] * rli[r] * 16.0f; v = __builtin_amdgcn_fmed3f(v, -448.0f, 448.0f);
                stg[orow * 128 + d0 * 32 + r32] = (unsigned char)(__builtin_amdgcn_cvt_pk_fp8_f32(v, v, 0, false) & 0xff); } }
        asm volatile("s_waitcnt lgkmcnt(0)" ::: "memory");
        int ln = lane; asm volatile("" : "+v"(ln));
        unsigned char* Ob = (unsigned char*)P.O + cur.qoff + (size_t)(wid * QBLK) * LD;
#pragma unroll
        for (int i = 0; i < 4; ++i) { const int row = i * 8 + (ln >> 3), ch = ln & 7;
            const u32x4 v = *(const u32x4*)(stg + row * 128 + ch * 16); *(u32x4*)(Ob + (size_t)row * LD + ch * 16) = v; }
        asm volatile("s_waitcnt lgkmcnt(0)" ::: "memory");
    } else {
        unsigned short* stg = (unsigned short*)(lds + QS_OFF + wid * 8192);
#pragma unroll
        for (int r = 0; r < 16; ++r) { const int orow = crow(r, hi);
#pragma unroll
            for (int d0 = 0; d0 < 4; ++d0) stg[orow * 128 + d0 * 32 + r32] = (unsigned short)(cvtpk(o[d0][r] * rli[r], 0.f) & 0xffffu); }
        asm volatile("s_waitcnt lgkmcnt(0)" ::: "memory");
        int ln = lane; asm volatile("" : "+v"(ln));
#pragma unroll
        for (int i = 0; i < 8; ++i) { const int row = i * 4 + (ln >> 4), ch = ln & 15;
            const u32x4 v = *(const u32x4*)(stg + row * 128 + ch * 8); *(u32x4*)(Ow + (size_t)row * LD + ch * 8) = v; if (i & 1) asm volatile("" ::: "memory"); }
        asm volatile("s_waitcnt lgkmcnt(0)" ::: "memory");
    }
    SBAR(); asm volatile("" ::: "memory");
    load_cb(P, nxt, lds, par ^ 1);
    __syncthreads();
#undef RESC
#undef KBASE
#undef MASKT
#undef SEAM_K0
#undef HALF_STEP
}
__device__ __forceinline__ BlockRef mk_ref(int L_, int pass) {
    const int bh = L_ >> 2, x = L_ & 3, qb = pass ? 7 - x : x, b = bh / NH, hh = bh - b * NH;
    BlockRef r; r.qoff = (unsigned)((b * SEQ + qb * QB) * DM + hh * HD); r.kvoff = (unsigned)(bh * SEQ * HD); r.cboff = (unsigned)(bh * SEQ); r.P0 = qb * QB; return r; }
#undef ROW
#undef VMW
#undef VMWN
#undef SLOAD_H
#undef SWRITE_HK
#undef SWRITE_HV
#undef SWRITE_H
#undef KSWZ
#undef SBAR
}

constexpr int NWAVES = 8;
typedef unsigned short bf16;
typedef unsigned v4u __attribute__((ext_vector_type(4)));
typedef float f32x4 __attribute__((ext_vector_type(4)));
typedef GAS unsigned gu32;
#define RLX_AGENT __ATOMIC_RELAXED, __HIP_MEMORY_SCOPE_AGENT
#define LDS_WAIT() asm volatile("s_waitcnt lgkmcnt(0)" ::: "memory")
#define VM_WAIT() asm volatile("s_waitcnt vmcnt(0)" ::: "memory")
__device__ __forceinline__ unsigned f2bf(float f) { unsigned u = __builtin_bit_cast(unsigned, f); return (u + 0x7fffu + ((u >> 16) & 1u)) >> 16; }
__device__ __forceinline__ unsigned pk2(float lo, float hi) { return f2bf(lo) | (f2bf(hi) << 16); }

constexpr size_t MiB = 1u << 20;
constexpr size_t al1(size_t x) { return (x + MiB - 1) / MiB * MiB; }
constexpr size_t WS_CTL = 0, CTL_ZERO_BYTES = 64 * 1024;
constexpr size_t SZ_TD = (size_t)T * DM * 2;
constexpr size_t WS_WCI = 1 * MiB;
constexpr size_t WS_WCO = WS_WCI + al1((size_t)3 * DM * DM * 2);
constexpr size_t WS_WGU = WS_WCO + al1((size_t)DM * DM * 2);
constexpr size_t WS_WFD = WS_WGU + al1((size_t)2 * DFF * DM * 2);
constexpr size_t WS_WPG = WS_WFD + al1((size_t)DM * DFF * 2);
constexpr size_t WS_WPU = WS_WPG + al1((size_t)2 * DM * DM * 2);
constexpr size_t WS_WQKV = WS_WPU + al1((size_t)2 * DM * PLE * 2);
constexpr size_t WS_WO = WS_WQKV + al1((size_t)3 * DM * DM * 2);
constexpr size_t WS_WMGU = WS_WO + al1((size_t)DM * DM * 2);
constexpr size_t WS_WMD = WS_WMGU + al1((size_t)NE * 2 * DFE * DM * 2);
constexpr size_t WS_WF = WS_WMD + al1((size_t)NE * DM * DFE * 2);
constexpr size_t WS_WR = WS_WF + al1((size_t)NH * DM * 4);
constexpr size_t WS_HB = WS_WR + al1((size_t)DM * NE * 4);
constexpr size_t WS_HB2 = WS_HB + al1(SZ_TD);
constexpr size_t WS_H8 = WS_HB2 + al1(SZ_TD);
constexpr size_t WS_H8B = WS_H8 + al1(SZ_TD / 2);
constexpr size_t WS_PB = WS_H8B + al1(SZ_TD / 2);
constexpr size_t WS_E0 = WS_PB + al1((size_t)2 * T * PLE * 2);
constexpr size_t WS_E1 = WS_E0 + SZ_TD;
constexpr size_t WS_U = WS_E1 + al1(SZ_TD);
constexpr size_t WS_BG = WS_U + al1(SZ_TD);
constexpr size_t WS_YB = WS_BG + al1(SZ_TD);
constexpr size_t WS_ACT = WS_YB + al1(SZ_TD);
constexpr size_t WS_Q = WS_ACT + al1((size_t)T * DFF * 2);
constexpr size_t WS_K = WS_Q + al1(SZ_TD);
constexpr size_t WS_V = WS_K + al1(SZ_TD);
constexpr size_t WS_O = WS_V + al1(SZ_TD);
constexpr size_t WS_LF = WS_O + al1(SZ_TD);
constexpr size_t WS_CB = WS_LF + al1((size_t)T * NH * 4);
constexpr size_t WS_SL1 = WS_CB + al1((size_t)T * NH * 4);
constexpr size_t WS_SL2 = WS_SL1 + al1((size_t)T * 32 * 4);
constexpr size_t WS_SL3 = WS_SL2 + al1((size_t)T * 32 * 4);
constexpr size_t WS_RSTD = WS_SL3 + al1((size_t)T * 32 * 4);
constexpr size_t WS_ROUTE = WS_RSTD + al1((size_t)3 * T * 4);
constexpr size_t WS_XG = WS_ROUTE + 1 * MiB;
constexpr size_t WS_RG = WS_XG + al1((size_t)MAXROWS * DM * 2);
constexpr size_t WS_ACTM = WS_RG + 1 * MiB;
constexpr size_t WS_YM = WS_ACTM + al1((size_t)MAXROWS * DFE * 2);
constexpr size_t WS_YP = WS_YM + al1((size_t)MAXROWS * DM * 4);
constexpr size_t WS_END = WS_YP + (size_t)256 * 65536 * 2;
constexpr int CW_SPLIT = 8192;
constexpr int CW_BAR = 1024;

constexpr int RING_OFF = 0, RING_BYTES = 131072;
constexpr int TAB_OFF = RING_BYTES;
constexpr int LDS_BYTES = 163840;
constexpr int MISC_OFF = LDS_BYTES - 512;
static_assert(TAB_OFF + 2048 + 8192 <= MISC_OFF, "LDS map (row-scale tables + the QKV epilogue's [256][8] reduction scratch)");
static_assert(fox::LDS_BYTES <= MISC_OFF, "attention LDS (overlays the row-scale tables, which are idle in that phase)");

#define XB_TMO      128
#define XB_XCNT(j)  (256  + 64 * (j))
#define XB_XSUB(j)  (1280 + 64 * (j))
#define XB_XGEN(j)  (2304 + 64 * (j))
#define XB_TOP      3328
#define XB_TOPGEN   3392
#define XCD_BAR_WORDS 3456
#define XB_SPIN_CAP (1u << 22)
__device__ __forceinline__ unsigned xb_ld(unsigned* p)              { return __hip_atomic_load(p, __ATOMIC_RELAXED, __HIP_MEMORY_SCOPE_AGENT); }
__device__ __forceinline__ unsigned xb_add(unsigned* p, unsigned v) { return __hip_atomic_fetch_add(p, v, __ATOMIC_RELAXED, __HIP_MEMORY_SCOPE_AGENT); }
__device__ __forceinline__ unsigned xb_xcc_id() { return (unsigned)__builtin_amdgcn_s_getreg((3 << 11) | 20) & 0xFu; }
#define XB_SPIN(cond, bar) do { unsigned _sp = 0; while (cond) { __builtin_amdgcn_s_sleep(1); \
    if ((++_sp & 255u) == 0u) { if (xb_ld(&(bar)[XB_TMO])) break; if (_sp > XB_SPIN_CAP) { atomicAdd(&(bar)[XB_TMO], 1u); break; } } } } while (0)
struct XcdBarrier { unsigned* bar; unsigned x; volatile LAS unsigned* st; };
__device__ __forceinline__ XcdBarrier xcd_barrier_post(unsigned* bar, volatile LAS unsigned* st) {
    XcdBarrier b; b.bar = bar; b.x = xb_xcc_id(); b.st = st;
    if (threadIdx.x == 0) st[3] = xb_add(&bar[XB_XCNT(b.x)], 1u);
    return b;
}
__device__ __forceinline__ void xcd_barrier_complete(unsigned* bar, unsigned x, unsigned& nloc, unsigned& nx, unsigned& uni) {
    const unsigned G = gridDim.x * gridDim.y * gridDim.z;
    unsigned sum, cnt, mine, sp = 0u;
    for (;;) {
        sum = 0u; cnt = 0u; mine = 0u;
#pragma unroll
        for (unsigned j = 0; j < 16; ++j) { const unsigned c = xb_ld(&bar[XB_XCNT(j)]); sum += c; cnt += (c > 0u) ? 1u : 0u; mine = (j == x) ? c : mine; }
        if (sum == G) break;
        __builtin_amdgcn_s_sleep(1);
        if ((++sp & 255u) == 0u) { if (xb_ld(&bar[XB_TMO])) break; if (sp > XB_SPIN_CAP) { atomicAdd(&bar[XB_TMO], 1u); break; } }
    }
    nloc = mine > 0u ? mine : 1u; nx = cnt > 0u ? cnt : 1u;
    uni = (sum == G && cnt == 8u && G % 8u == 0u) ? 1u : 0u;
#pragma unroll
    for (unsigned j = 0; j < 16; ++j) { const unsigned c = xb_ld(&bar[XB_XCNT(j)]); if (j < 8u ? c != G / 8u : c != 0u) uni = 0u; }
}
#ifndef EARLY_INV
#define EARLY_INV 1
#endif
__device__ __forceinline__ void xcd_barrier(const XcdBarrier& b, bool local = false) {
    asm volatile("s_waitcnt vmcnt(0)" ::: "memory");
    __syncthreads();
    if (threadIdx.x == 0) {
        unsigned* bar = b.bar;
        __builtin_amdgcn_s_waitcnt(0);
        unsigned nloc = b.st[0], nx = b.st[1];
        if (nloc == 0u) { unsigned uni; xcd_barrier_complete(bar, b.x, nloc, nx, uni); b.st[0] = nloc; b.st[1] = nx; b.st[2] = uni; }
        const bool loc = local && b.st[2] != 0u;
        if (EARLY_INV) asm volatile("buffer_inv sc1" ::: "memory");
        const unsigned old = xb_add(&bar[XB_XSUB(b.x)], 1u);
        const unsigned gen = old / nloc;
        if (loc) {
            const unsigned tgt = (gen + 1u) * nloc;
            XB_SPIN(xb_ld(&bar[XB_XSUB(b.x)]) < tgt, bar);
        } else {
            const unsigned gg = b.st[4]; b.st[4] = gg + 1u;
            if (old + 1u == (gen + 1u) * nloc) {
                __builtin_amdgcn_fence(__ATOMIC_RELEASE, "agent");
                asm volatile("s_waitcnt vmcnt(0)" ::: "memory");
                const unsigned og = xb_add(&bar[XB_TOP], 1u);
                if (og + 1u == (gg + 1u) * nx) {
#pragma unroll
                    for (unsigned j = 0; j < 16; ++j) (void)xb_add(&bar[XB_XGEN(j)], 1u);
                }
            }
            XB_SPIN(xb_ld(&bar[XB_XGEN(b.x)]) == gg, bar);
        }
        if (EARLY_INV) asm volatile("s_waitcnt vmcnt(0)" ::: "memory");
        else { __builtin_amdgcn_fence(__ATOMIC_ACQUIRE, "agent"); asm volatile("s_waitcnt vmcnt(0)" ::: "memory"); }
    }
    __syncthreads();
}

struct Frame {
    LAS unsigned char* lds;
    volatile LAS unsigned* MISC;
    LAS float* tab;
    gu32* ctl;
    int tid, lane, wave;
    int vcu, G;
    float* out; unsigned char* ws;
};
__device__ __forceinline__ const float* arg_in(int i) {
    const __attribute__((address_space(4))) char* ka = (const __attribute__((address_space(4))) char*)__builtin_amdgcn_kernarg_segment_ptr();
    asm volatile("" : "+s"(ka));
    return *(const float* const __attribute__((address_space(4)))*)(ka + 8 * i);
}

__device__ __forceinline__ float wave_sum(float v) {
#pragma unroll
    for (int o = 1; o < 64; o <<= 1) v += __shfl_xor(v, o);
    return v;
}

template <int W, int CNT> __device__ __forceinline__ void reduce_step(float (&v)[32], int lane) {
    const bool up = (lane & W) != 0;
#pragma unroll
    for (int k = 0; k < CNT; ++k) { const float send = up ? v[k] : v[k + CNT], keep = up ? v[k + CNT] : v[k]; v[k] = keep + __shfl_xor(send, W); }
}
__device__ __forceinline__ float reduce32(float (&v)[32], int lane) {
    reduce_step<32, 16>(v, lane); reduce_step<16, 8>(v, lane); reduce_step<8, 4>(v, lane); reduce_step<4, 2>(v, lane); reduce_step<2, 1>(v, lane);
    return v[0] + __shfl_xor(v[0], 1);
}
struct CvtJob { const float* W; int ld; int Kg; int groups; int N; const float* gain; int map; int F; bf16* dst; };
__device__ __forceinline__ int cvt_items(const CvtJob& j) { return j.groups * (j.Kg / 64) * (j.N / 32); }
__device__ __forceinline__ int map_col(int map, int F, int n0) {
    if (map == 1) { if (n0 < DM) return 2 * DM + n0; const int c = (n0 - DM) & (DM - 1), isx = (n0 >= 2 * DM); return 256 * (c >> 7) + (isx ? 128 : 0) + (c & 127); }
    if (map == 2) { const int isu = n0 >= F, c = isu ? n0 - F : n0; return 256 * (c >> 7) + (isu ? 128 : 0) + (c & 127); }
    return n0;
}
__device__ __forceinline__ void cvt_item(const CvtJob& j, LAS float* scr, int item, int lane) {
    const int nblk = j.N / 32, kpg = j.Kg / 64; const int kb = item / nblk, nb = item - kb * nblk, grp = kb / kpg, kl = kb - grp * kpg, k0 = 64 * kl, n0 = 32 * nb;
    const float* Wg = j.W + (size_t)grp * j.Kg * j.ld; const float* gn = j.gain ? j.gain + (size_t)grp * j.Kg : nullptr;
    float v[32];
    const float* src = Wg + (size_t)(k0 + (lane >> 5)) * j.ld + n0 + (lane & 31);
#pragma unroll
    for (int i = 0; i < 32; ++i) v[i] = src[(size_t)(2 * i) * j.ld];
    if (gn) {
#pragma unroll
        for (int i = 0; i < 32; ++i) v[i] *= gn[k0 + 2 * i + (lane >> 5)]; }
#pragma unroll
    for (int i = 0; i < 32; ++i) scr[(2 * i + (lane >> 5)) * 33 + (lane & 31)] = v[i];
    LDS_WAIT(); asm volatile("" ::: "memory");
    const int c = lane & 7; const int d0 = map_col(j.map, j.F, n0);
    bf16* D = j.dst + (size_t)grp * j.N * j.Kg;
#pragma unroll
    for (int q = 0; q < 4; ++q) { const int n = (lane >> 3) + 8 * q; const LAS float* s = scr + (8 * c) * 33 + n;
        v4u o; o.x = pk2(s[0 * 33], s[1 * 33]); o.y = pk2(s[2 * 33], s[3 * 33]); o.z = pk2(s[4 * 33], s[5 * 33]); o.w = pk2(s[6 * 33], s[7 * 33]);
        *(GAS v4u*)(D + (size_t)(d0 + n) * j.Kg + k0 + 8 * c) = o; }
    LDS_WAIT(); asm volatile("" ::: "memory");
}
__device__ __forceinline__ void cvt8_load(const CvtJob& j, int item, int lane, float (&v)[64]) {
    const int nblk = j.N / 32, kpg = j.Kg / 128; const int kb = item / nblk, nb = item - kb * nblk, grp = kb / kpg, kl = kb - grp * kpg, k0 = 128 * kl, n0 = 32 * nb;
    const float* src = j.W + (size_t)grp * j.Kg * j.ld + (size_t)(k0 + (lane >> 5)) * j.ld + n0 + (lane & 31);
#pragma unroll
    for (int i = 0; i < 64; ++i) v[i] = __builtin_nontemporal_load(src + (size_t)(2 * i) * j.ld);
}
__device__ __forceinline__ void cvt8_finish(const CvtJob& j, float wscale, const LAS float* gtab, LAS float* scr, int item, int lane, const float (&v)[64]) {
    const int nblk = j.N / 32, kpg = j.Kg / 128; const int kb = item / nblk, nb = item - kb * nblk, grp = kb / kpg, kl = kb - grp * kpg, k0 = 128 * kl, n0 = 32 * nb;
#pragma unroll
    for (int i = 0; i < 64; ++i) scr[(2 * i + (lane >> 5)) * 33 + (lane & 31)] = v[i] * wscale;
    LDS_WAIT(); asm volatile("" ::: "memory");
    const int c = lane & 7; const int d0 = map_col(j.map, j.F, n0);
    unsigned char* D = (unsigned char*)j.dst + (size_t)grp * j.N * j.Kg;
    float g[16];
#pragma unroll
    for (int i = 0; i < 16; ++i) g[i] = gtab ? gtab[k0 + 16 * c + i] : 1.0f;
#pragma unroll
    for (int q = 0; q < 4; ++q) { const int n = (lane >> 3) + 8 * q; const LAS float* s = scr + (16 * c) * 33 + n;
        v4u o; o.x = pg8::pk4_fp8(s[0 * 33] * g[0], s[1 * 33] * g[1], s[2 * 33] * g[2], s[3 * 33] * g[3]); o.y = pg8::pk4_fp8(s[4 * 33] * g[4], s[5 * 33] * g[5], s[6 * 33] * g[6], s[7 * 33] * g[7]);
        o.z = pg8::pk4_fp8(s[8 * 33] * g[8], s[9 * 33] * g[9], s[10 * 33] * g[10], s[11 * 33] * g[11]); o.w = pg8::pk4_fp8(s[12 * 33] * g[12], s[13 * 33] * g[13], s[14 * 33] * g[14], s[15 * 33] * g[15]);
        __builtin_nontemporal_store(o, (GAS v4u*)(D + (size_t)(d0 + n) * j.Kg + k0 + 16 * c)); }
    LDS_WAIT(); asm volatile("" ::: "memory");
}
__device__ __forceinline__ void cvt_item8(const CvtJob& j, float wscale, LAS float* scr, int item, int lane) {
    float v[64]; cvt8_load(j, item, lane, v);
    if (j.gain) { const int nblk = j.N / 32, kpg = j.Kg / 128; const int kb = item / nblk, kl = kb % kpg, k0 = 128 * kl;
#pragma unroll
        for (int i = 0; i < 64; ++i) v[i] *= j.gain[k0 + 2 * i + (lane >> 5)]; }
    cvt8_finish(j, wscale, nullptr, scr, item, lane, v);
}
__device__ __forceinline__ void cvt8_range(const CvtJob& j, float wscale, const LAS float* gtab, LAS float* scr, int lo, int hi, int gw, int NGW, int lane) {
    int it = lo + gw; if (it >= hi) return;
    float va[64], vb[64]; cvt8_load(j, it, lane, va);
    for (;;) {
        int nx = it + NGW; bool hn = nx < hi;
        if (hn) cvt8_load(j, nx, lane, vb);
        cvt8_finish(j, wscale, gtab, scr, it, lane, va);
        if (!hn) break;
        it = nx; nx = it + NGW; hn = nx < hi;
        if (hn) cvt8_load(j, nx, lane, va);
        cvt8_finish(j, wscale, gtab, scr, it, lane, vb);
        if (!hn) break;
        it = nx;
    }
}
#ifndef FP8_PLE1
#define FP8_PLE1 true
#endif
#ifndef FP8_PLE0
#define FP8_PLE0 true
#endif
#ifndef FP8_QKV
#define FP8_QKV true
#endif
#ifndef FP8_FFN
#define FP8_FFN true
#endif
constexpr float WSC_GU = 1024.0f, WSC_DN = 2048.0f, ASC_X = 16.0f, ASC_ACT = 8.0f;
typedef float v4f __attribute__((ext_vector_type(4)));
__device__ __forceinline__ void cvtd_load(const CvtJob& j, int item, bool ok, int lane, v4f (&v)[16]) {
    const int nblk = j.N / 32, kpg = j.Kg / 128; const int kb = item / nblk, nb = item - kb * nblk, grp = kb / kpg, kl = kb - grp * kpg, k0 = 128 * kl, n0 = 32 * nb;
    const size_t rs = ok ? (size_t)j.ld : 0;
    const float* src = j.W + (ok ? (size_t)grp * j.Kg * j.ld + (size_t)(k0 + 16 * (lane >> 3)) * j.ld + n0 : (size_t)0) + 4 * (lane & 7);
#pragma unroll
    for (int i = 0; i < 16; ++i) v[i] = __builtin_nontemporal_load((const v4f*)(src + (size_t)i * rs));
}
__device__ __forceinline__ void cvtd_finish(const CvtJob& j, float wscale, bool useg, const LAS float* gtab, int item, int lane, const v4f (&v)[16]) {
    const int nblk = j.N / 32, kpg = j.Kg / 128; const int kb = item / nblk, nb = item - kb * nblk, grp = kb / kpg, kl = kb - grp * kpg, k0 = 128 * kl, n0 = 32 * nb;
    const int r = lane >> 3, cc = lane & 7; const int d0 = map_col(j.map, j.F, n0);
    unsigned char* D = (unsigned char*)j.dst + (size_t)grp * j.N * j.Kg + (size_t)(d0 + 4 * cc) * j.Kg + k0 + 16 * r;
    float g[16];
    if (useg) {
#pragma unroll
        for (int m = 0; m < 4; ++m) { const v4f t = *(const LAS v4f*)(gtab + k0 + 16 * r + 4 * m); g[4 * m] = t[0]; g[4 * m + 1] = t[1]; g[4 * m + 2] = t[2]; g[4 * m + 3] = t[3]; }
    } else {
#pragma unroll
        for (int i = 0; i < 16; ++i) g[i] = wscale;
    }
#pragma unroll
    for (int q = 0; q < 4; ++q) {
        v4u o; o.x = pg8::pk4_fp8(v[0][q] * g[0], v[1][q] * g[1], v[2][q] * g[2], v[3][q] * g[3]); o.y = pg8::pk4_fp8(v[4][q] * g[4], v[5][q] * g[5], v[6][q] * g[6], v[7][q] * g[7]);
        o.z = pg8::pk4_fp8(v[8][q] * g[8], v[9][q] * g[9], v[10][q] * g[10], v[11][q] * g[11]); o.w = pg8::pk4_fp8(v[12][q] * g[12], v[13][q] * g[13], v[14][q] * g[14], v[15][q] * g[15]);
        __builtin_nontemporal_store(o, (GAS v4u*)(D + (size_t)q * j.Kg)); }
}
__device__ __forceinline__ void cvtd_range(const CvtJob& j, float wscale, bool useg, const LAS float* gtab, int first, int hi, int NGW, int lane) {
    int it = first; if (it >= hi) return;
    int nl = it;
    v4f va[16], vb[16], vc[16];
#define CVTD_LOADN(v) do { cvtd_load(j, nl, nl < hi, lane, v); nl += NGW; } while (0)
    CVTD_LOADN(va); CVTD_LOADN(vb);
    for (;;) {
        CVTD_LOADN(vc); cvtd_finish(j, wscale, useg, gtab, it, lane, va); it += NGW; if (it >= hi) break;
        CVTD_LOADN(va); cvtd_finish(j, wscale, useg, gtab, it, lane, vb); it += NGW; if (it >= hi) break;
        CVTD_LOADN(vb); cvtd_finish(j, wscale, useg, gtab, it, lane, vc); it += NGW; if (it >= hi) break;
    }
#undef CVTD_LOADN
}
#ifndef PROBE_CVTREP
#define PROBE_CVTREP 1
#endif
#ifndef BG_B1
#define BG_B1 18
#define BG_B2 36
#define BG_B3 56
#define BG_B4 84
#endif
#ifndef BGCVT
#define BGCVT 4
#endif
static_assert(FP8_FFN && FP8_PLE0 && FP8_PLE1 && FP8_QKV && FP8_WO, "the background conversion list assumes these weights are fp8");
__device__ __forceinline__ void bg_job(int jb, unsigned char* ws, CvtJob& j, float& wscale, const float*& gain) {
    switch (jb) {
    case 0:  j = CvtJob{arg_in(15), 2 * DFF, DM, 1, 2 * DFF, nullptr, 2, DFF, (bf16*)(ws + WS_WGU)}; wscale = WSC_GU; gain = arg_in(3); break;
    case 1:  j = CvtJob{arg_in(16), DM, DFF, 1, DM, nullptr, 0, 0, (bf16*)(ws + WS_WFD)}; wscale = WSC_DN; gain = nullptr; break;
    case 2:  j = CvtJob{arg_in(21), DM, DM, 1, DM, nullptr, 0, 0, (bf16*)(ws + WS_WPG)}; wscale = WSC_GU; gain = arg_in(4); break;
    case 3:  j = CvtJob{arg_in(12), DM, DM, 1, DM, nullptr, 0, 0, (bf16*)(ws + WS_WQKV)}; wscale = WSC_GU; gain = arg_in(2) + DM; break;
    case 4:  j = CvtJob{arg_in(9), 2 * DM + NH, DM, 1, 2 * DM, nullptr, 0, 0, (bf16*)(ws + WS_WQKV + (size_t)DM * DM)}; wscale = WSC_GU; gain = arg_in(8); break;
    case 5:  j = CvtJob{arg_in(14), DM, DM, 1, DM, nullptr, 0, 0, (bf16*)(ws + WS_WO)}; wscale = WSC_GU; gain = nullptr; break;
    case 6:  j = CvtJob{arg_in(21) + (size_t)DM * DM, DM, DM, 1, DM, nullptr, 0, 0, (bf16*)(ws + WS_WPG) + (size_t)DM * DM}; wscale = WSC_GU; gain = arg_in(4) + DM; break;
    case 7:  j = CvtJob{arg_in(18), 2 * DFE, DM, NE, 2 * DFE, nullptr, 2, DFE, (bf16*)(ws + WS_WMGU)}; wscale = WSC_GU; gain = arg_in(3) + DM; break;
    default: j = CvtJob{arg_in(19), DM, DFE, NE, DM, nullptr, 0, 0, (bf16*)(ws + WS_WMD)}; wscale = WSC_DN; gain = nullptr; break;
    }
}
constexpr int BG_IGU = NE * (DM / 128) * (2 * DFE / 32), BG_IDN = NE * (DFE / 128) * (DM / 32), BG_I1K = (DM / 128) * (DM / 32);
constexpr int BG_GA = 11264, BG_GB = 35840;
constexpr int BG_NSEG = 11;
constexpr int BG_SEGJOB[BG_NSEG] = {0, 1, 2, 3, 4, 7, 7, 5, 6, 7, 8};
constexpr int BG_SEGLO[BG_NSEG]  = {0, 0, 0, 0, 0, 0, BG_GA, 0, 0, BG_GB, 0};
constexpr int BG_SEGN[BG_NSEG]   = {(DM / 128) * (2 * DFF / 32), (DFF / 128) * (DM / 32), BG_I1K, BG_I1K, (DM / 128) * (2 * DM / 32), BG_GA, BG_GB - BG_GA, BG_I1K, BG_I1K, BG_IGU - BG_GB, BG_IDN};
constexpr int BG_SLOT[5] = {0, 6, 7, 10, 11};
__device__ __forceinline__ void moe_cvt_slot(Frame& F, int s, int nslot) {
    int lane = F.lane, wave = F.wave, tid = F.tid;
    asm volatile("" : "+v"(lane)); asm volatile("" : "+s"(wave)); asm volatile("" : "+v"(tid));
    const int gw = F.vcu * NWAVES + wave, NGW = F.G * NWAVES;
    unsigned char* ws = F.ws;
    LAS float* gtab = (LAS float*)(F.lds + RING_OFF);
    int sg0 = BG_SLOT[0], sg1 = BG_SLOT[4];
#pragma unroll
    for (int k = 0; k < 4; ++k) if (nslot > 1 && s == k) { sg0 = BG_SLOT[k]; sg1 = BG_SLOT[k + 1]; }
    int vbase = 0;
#pragma nounroll
    for (int sg = sg0; sg < sg1; ++sg) {
        int q = sg; asm volatile("" : "+s"(q));
        int jb = 0, slo = 0, sn = 0;
#pragma unroll
        for (int k = 0; k < BG_NSEG; ++k) if (q == k) { jb = BG_SEGJOB[k]; slo = BG_SEGLO[k]; sn = BG_SEGN[k]; }
        CvtJob j; float wscale; const float* gain; bg_job(jb, ws, j, wscale, gain);
        __syncthreads();
        if (gain) { for (int i = tid; i < DM; i += NWAVES * 64) gtab[i] = gain[i] * wscale; }
        LDS_WAIT(); __syncthreads();
        int i0 = (gw - vbase) % NGW; if (i0 < 0) i0 += NGW;
        cvtd_range(j, wscale, gain != nullptr, gtab, slo + i0, slo + sn, NGW, lane);
        vbase += sn;
    }
    LDS_WAIT(); __syncthreads();
}
__device__ __forceinline__ void p0_prologue(Frame& F) {
    LAS float* scr = (LAS float*)(F.lds + RING_OFF + F.wave * 17408);
    const int gw = F.vcu * NWAVES + F.wave, NGW = F.G * NWAVES;
    unsigned char* ws = F.ws;
    constexpr int I0 = (DM / 64) * (3 * DM / 32), I1 = (DM / 64) * (DM / 32), I2 = (DM / (FP8_FFN ? 128 : 64)) * (2 * DFF / 32), I3 = (DFF / (FP8_FFN ? 128 : 64)) * (DM / 32), I4A = (DM / (FP8_PLE0 ? 128 : 64)) * (DM / 32), I4B = FP8_PLE1 ? (DM / 128) * (DM / 32) : I4A, I4 = I4A + I4B, I5 = 2 * (PLE / 64) * (DM / 32),
                  I6 = FP8_QKV ? (DM / 128) * (DM / 32) : I1, I7 = (DM / (FP8_QKV ? 128 : 64)) * (2 * DM / 32), I8 = FP8_WO ? (DM / 128) * (DM / 32) : I1, I9P = (DM / 128) * (2 * DFE / 32), I9 = NE * I9P, I10 = NE * (DFE / 128) * (DM / 32);
    constexpr int NITEMS = I0 + I1 + I5;
    for (int it = gw; it < NITEMS; it += NGW) {
        int r = it;
        if (r < I0) { const CvtJob j{arg_in(5), 3 * DM, DM, 1, 3 * DM, arg_in(2), 1, 0, (bf16*)(ws + WS_WCI)}; cvt_item(j, scr, r, F.lane); continue; } r -= I0;
        if (r < I1) { const CvtJob j{arg_in(7), DM, DM, 1, DM, nullptr, 0, 0, (bf16*)(ws + WS_WCO)}; cvt_item(j, scr, r, F.lane); continue; } r -= I1;
        { const CvtJob j{arg_in(20), DM, PLE, 2, DM, nullptr, 0, 0, (bf16*)(ws + WS_WPU)}; cvt_item(j, scr, r, F.lane); }
        (void)I2; (void)I3; (void)I4; (void)I6; (void)I7; (void)I8; (void)I9P; (void)I9; (void)I10;
    }
    static_assert(BGCVT == 4, "the fp8 weights are converted by the four background slots only");
    {
        const int gt = gw * 64 + F.lane, NGT = NGW * 64;
        float* Wf = (float*)(ws + WS_WF); float* Wr = (float*)(ws + WS_WR);
        for (int i = gt; i < NH * DM; i += NGT) { const int h = i / DM, k = i - h * DM; Wf[i] = arg_in(8)[k] * arg_in(9)[(size_t)k * (2 * DM + NH) + 2 * DM + h]; }
        for (int i = gt; i < DM * NE; i += NGT) { const int k = i / NE; Wr[i] = arg_in(3)[DM + k] * arg_in(17)[i]; }
        const f32x4* p4 = (const f32x4*)arg_in(1); unsigned long long* pb = (unsigned long long*)(ws + WS_PB);
#pragma unroll 8
        for (int i = gt; i < 2 * T * PLE / 4; i += NGT) { const f32x4 v = p4[i]; pb[i] = (unsigned long long)pk2(v[0], v[1]) | ((unsigned long long)pk2(v[2], v[3]) << 32); }
    }
    {
        const float* x = arg_in(0); bf16* hb = (bf16*)(ws + WS_HB); float* rstd0 = (float*)(ws + WS_RSTD);
        for (int mb = gw; mb < T; mb += 4 * NGW) {
            f32x4 v[4][4][2];
#pragma unroll
            for (int t = 0; t < 4; ++t) { const int m = (mb + t * NGW < T) ? mb + t * NGW : mb; const f32x4* xr = (const f32x4*)(x + (size_t)m * DM) + 2 * F.lane;
#pragma unroll
                for (int j = 0; j < 4; ++j) { v[t][j][0] = xr[128 * j]; v[t][j][1] = xr[128 * j + 1]; } }
#pragma unroll
            for (int t = 0; t < 4; ++t) { if (mb + t * NGW >= T) break; const int m = mb + t * NGW; float s = 0.f;
#pragma unroll
                for (int j = 0; j < 4; ++j) s += (v[t][j][0][0] * v[t][j][0][0] + v[t][j][0][1] * v[t][j][0][1]) + (v[t][j][0][2] * v[t][j][0][2] + v[t][j][0][3] * v[t][j][0][3]) + (v[t][j][1][0] * v[t][j][1][0] + v[t][j][1][1] * v[t][j][1][1]) + (v[t][j][1][2] * v[t][j][1][2] + v[t][j][1][3] * v[t][j][1][3]);
                s = wave_sum(s);
                if (F.lane == 0) rstd0[m] = 1.0f / sqrtf(s * (1.0f / DM) + RMS_EPS);
                v4u* o = (v4u*)(hb + (size_t)m * DM) + F.lane;
#pragma unroll
                for (int j = 0; j < 4; ++j) { v4u w; w.x = pk2(v[t][j][0][0], v[t][j][0][1]); w.y = pk2(v[t][j][0][2], v[t][j][0][3]); w.z = pk2(v[t][j][1][0], v[t][j][1][1]); w.w = pk2(v[t][j][1][2], v[t][j][1][3]); o[64 * j] = w; } }
        }
    }
}

__device__ __forceinline__ void p3_conv(Frame& F) {
    const int gw = F.vcu * NWAVES + F.wave, NGW = F.G * NWAVES;
    const bf16* U = (const bf16*)(F.ws + WS_U); const bf16* BG = (const bf16*)(F.ws + WS_BG); bf16* Y = (bf16*)(F.ws + WS_YB);
    const float* wd = arg_in(6);
    for (int it = gw; it < (T / 16) * 4; it += NGW) {
        const int strip = it >> 2, cq = it & 3, t0 = strip * 16, c0 = cq * 512 + F.lane * 8;
        float w0[8], w1[8], w2[8];
#pragma unroll
        for (int j = 0; j < 8; ++j) { w0[j] = wd[c0 + j]; w1[j] = wd[DM + c0 + j]; w2[j] = wd[2 * DM + c0 + j]; }
        float um2[8], um1[8];
        const bool first = (t0 % SEQ) == 0;
        if (first) {
#pragma unroll
            for (int j = 0; j < 8; ++j) { um2[j] = 0.f; um1[j] = 0.f; }
        } else {
            const v4u a = *(const v4u*)(U + (size_t)(t0 - 2) * DM + c0), b = *(const v4u*)(U + (size_t)(t0 - 1) * DM + c0);
            um2[0] = pg8::bf_lo(a.x); um2[1] = pg8::bf_hi(a.x); um2[2] = pg8::bf_lo(a.y); um2[3] = pg8::bf_hi(a.y); um2[4] = pg8::bf_lo(a.z); um2[5] = pg8::bf_hi(a.z); um2[6] = pg8::bf_lo(a.w); um2[7] = pg8::bf_hi(a.w);
            um1[0] = pg8::bf_lo(b.x); um1[1] = pg8::bf_hi(b.x); um1[2] = pg8::bf_lo(b.y); um1[3] = pg8::bf_hi(b.y); um1[4] = pg8::bf_lo(b.z); um1[5] = pg8::bf_hi(b.z); um1[6] = pg8::bf_lo(b.w); um1[7] = pg8::bf_hi(b.w);
        }
        v4u ua[16], ga[16];
#pragma unroll
        for (int r = 0; r < 16; ++r) { ua[r] = *(const v4u*)(U + (size_t)(t0 + r) * DM + c0); ga[r] = *(const v4u*)(BG + (size_t)(t0 + r) * DM + c0); }
#pragma unroll
        for (int r = 0; r < 16; ++r) {
            const v4u a = ua[r], g = ga[r];
            float u0[8], gg[8], y[8];
            u0[0] = pg8::bf_lo(a.x); u0[1] = pg8::bf_hi(a.x); u0[2] = pg8::bf_lo(a.y); u0[3] = pg8::bf_hi(a.y); u0[4] = pg8::bf_lo(a.z); u0[5] = pg8::bf_hi(a.z); u0[6] = pg8::bf_lo(a.w); u0[7] = pg8::bf_hi(a.w);
            gg[0] = pg8::bf_lo(g.x); gg[1] = pg8::bf_hi(g.x); gg[2] = pg8::bf_lo(g.y); gg[3] = pg8::bf_hi(g.y); gg[4] = pg8::bf_lo(g.z); gg[5] = pg8::bf_hi(g.z); gg[6] = pg8::bf_lo(g.w); gg[7] = pg8::bf_hi(g.w);
#pragma unroll
            for (int j = 0; j < 8; ++j) { y[j] = gg[j] * (w0[j] * um2[j] + w1[j] * um1[j] + w2[j] * u0[j]); um2[j] = um1[j]; um1[j] = u0[j]; }
            v4u o; o.x = pk2(y[0], y[1]); o.y = pk2(y[2], y[3]); o.z = pk2(y[4], y[5]); o.w = pk2(y[6], y[7]);
            *(v4u*)(Y + (size_t)(t0 + r) * DM + c0) = o;
        }
    }
}

__device__ __forceinline__ void p9_flogit(Frame& F, const bf16* hb, const float* slots) {
    typedef short bf16x8_t __attribute__((ext_vector_type(8)));
    const float* Wf = (const float*)(F.ws + WS_WF); float* LF = (float*)(F.ws + WS_LF);
    constexpr int NT16 = T / 16, TPC = NWAVES / 4;
    LAS f32x4* red = (LAS f32x4*)(F.lds + RING_OFF);
    for (int tb = F.vcu * TPC; tb < NT16; tb += F.G * TPC) {
        const int task = tb + (F.wave >> 2), kp = F.wave & 3; const bool act = task < NT16;
        const int t0 = (act ? task : 0) * 16, r16 = F.lane & 15, kq = F.lane >> 4;
        const bf16* ap = hb + (size_t)(t0 + r16) * DM + kq * 8 + kp * 512; const float* bp = Wf + (size_t)r16 * DM + kq * 8 + kp * 512;
        f32x4 acc = {0.f, 0.f, 0.f, 0.f};
        if (act) {
#pragma unroll
            for (int ks = 0; ks < 16; ++ks) {
                const bf16x8_t af = *(const bf16x8_t*)(ap + ks * 32);
                const f32x4 b0 = *(const f32x4*)(bp + ks * 32), b1 = *(const f32x4*)(bp + ks * 32 + 4);
                v4u bw; bw.x = pk2(b0[0], b0[1]); bw.y = pk2(b0[2], b0[3]); bw.z = pk2(b1[0], b1[1]); bw.w = pk2(b1[2], b1[3]);
                acc = __builtin_amdgcn_mfma_f32_16x16x32_bf16(af, __builtin_bit_cast(bf16x8_t, bw), acc, 0, 0, 0);
            }
        }
        red[F.wave * 64 + F.lane] = acc;
        LDS_WAIT(); __syncthreads();
        if (act && kp == 0) {
            acc = ((red[F.wave * 64 + F.lane] + red[(F.wave + 1) * 64 + F.lane]) + red[(F.wave + 2) * 64 + F.lane]) + red[(F.wave + 3) * 64 + F.lane];
            float ssq = 0.f; { const f32x4* sp = (const f32x4*)(slots + (size_t)(t0 + (F.lane >> 2)) * 32 + (F.lane & 3) * 8); const f32x4 u = sp[0], v = sp[1]; ssq = ((u[0] + u[1]) + (u[2] + u[3])) + ((v[0] + v[1]) + (v[2] + v[3])); }
            ssq += __shfl_xor(ssq, 1); ssq += __shfl_xor(ssq, 2);
            const float rstd_l = 1.0f / sqrtf(ssq * (1.0f / DM) + RMS_EPS);
            const float bfh = arg_in(10)[r16]; f32x4 o;
#pragma unroll
            for (int j = 0; j < 4; ++j) { const float rs = __shfl(rstd_l, 4 * (4 * kq + j)); const float f = rs * acc[j] + bfh;
                o[j] = (f >= 0.f) ? -log1pf(expf(-f)) : f - log1pf(expf(f)); }
            const int tq = t0 + 4 * kq, bb = tq / SEQ, sq = tq - bb * SEQ;
            *(f32x4*)(LF + ((size_t)bb * NH + r16) * SEQ + sq) = o;
        }
        __syncthreads();
    }
}
struct RouteBufs { int* e; float* w; int* rank; int* row; int* hist; };
__device__ __forceinline__ RouteBufs route_bufs(unsigned char* ws) { RouteBufs r; unsigned char* b = ws + WS_ROUTE; r.e = (int*)b; r.w = (float*)(b + 65536); r.rank = (int*)(b + 131072); r.row = (int*)(b + 196608); r.hist = (int*)(b + 262144); return r; }
__device__ __forceinline__ void p13_route(Frame& F) {
    const bf16* h = (const bf16*)(F.ws + WS_HB); const float* Wr = (const float*)(F.ws + WS_WR); float* rstd4 = (float*)(F.ws + WS_RSTD) + T;
    const RouteBufs R = route_bufs(F.ws);
    LAS int* le = (LAS int*)(F.lds + RING_OFF);
    for (int ch = F.vcu; ch < T / 32; ch += F.G) {
        {
            const int m0 = ch * 32 + F.wave * 4;
            float ss[4] = {0.f, 0.f, 0.f, 0.f}; float lg[32];
#pragma unroll
            for (int k = 0; k < 32; ++k) lg[k] = 0.f;
#pragma unroll
            for (int j = 0; j < 4; ++j) { const int c8 = j * 64 + F.lane; v4u a[4];
#pragma unroll
                for (int i = 0; i < 4; ++i) a[i] = *((const v4u*)(h + (size_t)(m0 + i) * DM) + c8);
                const f32x4* wp = (const f32x4*)(Wr + (size_t)c8 * 8 * NE);
#pragma unroll
                for (int q = 0; q < 8; ++q) { const f32x4 wa = wp[2 * q], wb = wp[2 * q + 1];
#pragma unroll
                    for (int i = 0; i < 4; ++i) { const unsigned wd = (q < 2) ? a[i].x : (q < 4) ? a[i].y : (q < 6) ? a[i].z : a[i].w; const float v = (q & 1) ? pg8::bf_hi(wd) : pg8::bf_lo(wd);
                        ss[i] += v * v;
                        lg[8 * i + 0] += v * wa[0]; lg[8 * i + 1] += v * wa[1]; lg[8 * i + 2] += v * wa[2]; lg[8 * i + 3] += v * wa[3]; lg[8 * i + 4] += v * wb[0]; lg[8 * i + 5] += v * wb[1]; lg[8 * i + 6] += v * wb[2]; lg[8 * i + 7] += v * wb[3]; } } }
            const float tot = reduce32(lg, F.lane);
#pragma unroll
            for (int i = 0; i < 4; ++i) {
                const float ssum = wave_sum(ss[i]); const float rstd = 1.0f / sqrtf(ssum * (1.0f / DM) + RMS_EPS);
                float l8[NE];
#pragma unroll
                for (int e = 0; e < NE; ++e) l8[e] = __uint_as_float(__builtin_amdgcn_readlane(__float_as_uint(tot), 2 * (8 * i + e)));
                int e1 = 0; float v1 = l8[0];
#pragma unroll
                for (int e = 1; e < NE; ++e) if (l8[e] > v1) { v1 = l8[e]; e1 = e; }
                int e2 = -1; float v2 = -3.0e38f;
#pragma unroll
                for (int e = 0; e < NE; ++e) if (e != e1 && l8[e] > v2) { v2 = l8[e]; e2 = e; }
                const float w1 = 1.0f / (1.0f + expf((v2 - v1) * rstd)), w2 = 1.0f - w1;
                const int tl = F.wave * 4 + i, m = m0 + i;
                if (F.lane == 0) { rstd4[m] = rstd; R.e[2 * m] = e1; R.e[2 * m + 1] = e2; R.w[2 * m] = w1; R.w[2 * m + 1] = w2; le[2 * tl] = e1; le[2 * tl + 1] = e2; }
            }
        }
        LDS_WAIT(); __syncthreads();
        if (F.wave == 0) { const int ei = le[F.lane]; int rank = 0;
#pragma unroll
            for (int e = 0; e < NE; ++e) { const unsigned long long mk = __ballot(ei == e); if (ei == e) rank = __popcll(mk & ((1ull << F.lane) - 1ull)); if (F.lane == 0) R.hist[ch * NE + e] = __popcll(mk); }
            R.rank[ch * 64 + F.lane] = rank; }
        __syncthreads();
    }
}
__device__ __forceinline__ void p14_gather(Frame& F, const bf16* hb) {
    const RouteBufs R = route_bufs(F.ws); const float* rstd4 = (const float*)(F.ws + WS_RSTD) + T;
    bf16* XG = (bf16*)(F.ws + WS_XG);
    LAS int* sm = (LAS int*)(F.lds + RING_OFF + 1024);
    for (int ch = F.vcu; ch < T / 32; ch += F.G) {
        { const int e = F.wave; int below = 0, tot = 0;
#pragma unroll
            for (int q = 0; q < 4; ++q) { const int c2 = q * 64 + F.lane; const int v = R.hist[c2 * NE + e]; tot += v; below += (c2 < ch) ? v : 0; }
#pragma unroll
            for (int o = 1; o < 64; o <<= 1) { tot += __shfl_xor(tot, o); below += __shfl_xor(below, o); }
            if (F.lane == 0) { sm[e] = below; sm[8 + e] = tot; } }
        LDS_WAIT(); __syncthreads();
        if (F.tid == 0) { int s = 0; for (int e = 0; e < NE; ++e) { sm[16 + e] = s; s += (sm[8 + e] + 255) / 256 * 256; } }
        LDS_WAIT(); __syncthreads();
        {
            const int m0 = ch * 32 + F.wave * 4; v4u ra[4][2][2];
#pragma unroll
            for (int i = 0; i < 4; ++i) { const v4u* src = (const v4u*)(hb + (size_t)(m0 + i) * DM);
#pragma unroll
                for (int q = 0; q < 2; ++q) { ra[i][q][0] = src[2 * (q * 64 + F.lane)]; ra[i][q][1] = src[2 * (q * 64 + F.lane) + 1]; } }
#pragma unroll
            for (int i = 0; i < 4; ++i) { const int tl = F.wave * 4 + i, m = m0 + i; const float xs = rstd4[m] * ASC_X; v4u o[2];
#pragma unroll
                for (int q = 0; q < 2; ++q) { const v4u a = ra[i][q][0], b = ra[i][q][1];
                    o[q].x = pg8::pk4_fp8(pg8::bf_lo(a.x) * xs, pg8::bf_hi(a.x) * xs, pg8::bf_lo(a.y) * xs, pg8::bf_hi(a.y) * xs); o[q].y = pg8::pk4_fp8(pg8::bf_lo(a.z) * xs, pg8::bf_hi(a.z) * xs, pg8::bf_lo(a.w) * xs, pg8::bf_hi(a.w) * xs);
                    o[q].z = pg8::pk4_fp8(pg8::bf_lo(b.x) * xs, pg8::bf_hi(b.x) * xs, pg8::bf_lo(b.y) * xs, pg8::bf_hi(b.y) * xs); o[q].w = pg8::pk4_fp8(pg8::bf_lo(b.z) * xs, pg8::bf_hi(b.z) * xs, pg8::bf_lo(b.w) * xs, pg8::bf_hi(b.w) * xs); }
#pragma unroll
                for (int k = 0; k < 2; ++k) { const int e = R.e[2 * m + k]; const int dst = sm[16 + e] + sm[e] + R.rank[ch * 64 + 2 * tl + k];
                    v4u* d = (v4u*)((unsigned char*)XG + (size_t)dst * DM); d[F.lane] = o[0]; d[64 + F.lane] = o[1];
                    if (F.lane == 0) R.row[2 * m + k] = dst; } }
        }
        { const int e = F.wave, tot = sm[8 + e], padn = (256 - (tot & 255)) & 255;
          if (ch < padn) { const int dst = sm[16 + e] + tot + ch; v4u* d = (v4u*)((unsigned char*)XG + (size_t)dst * DM); const v4u z = {0u, 0u, 0u, 0u};
#pragma unroll
              for (int q = 0; q < 2; ++q) d[q * 64 + F.lane] = z;
              }
          if (ch == 0 && F.lane == 0) ((int*)(F.ws + WS_ROUTE + 300000))[e] = (tot + 255) / 256; }
        __syncthreads();
    }
}
__device__ __forceinline__ void p17_combine(Frame& F, const bf16* hin, bf16* hb, unsigned char* h8) {
    const int gw = F.vcu * NWAVES + F.wave, NGW = F.G * NWAVES;
    const RouteBufs R = route_bufs(F.ws); const bf16* YM = (const bf16*)(F.ws + WS_YM); float* rstd5 = (float*)(F.ws + WS_RSTD) + 2 * T;
    for (int mb = gw; mb < T; mb += 2 * NGW) {
        int mm[2], r0[2], r1[2]; float w0[2], w1[2];
#pragma unroll
        for (int t = 0; t < 2; ++t) { int m = (mb + t * NGW < T) ? mb + t * NGW : mb; if (4 * NGW == T) m = 4 * (m % NGW) + m / NGW;
            mm[t] = m; r0[t] = R.row[2 * m]; r1[t] = R.row[2 * m + 1]; w0[t] = R.w[2 * m]; w1[t] = R.w[2 * m + 1]; }
        v4u ya[2][4], yb[2][4], hh[2][4];
#pragma unroll
        for (int t = 0; t < 2; ++t) { const v4u* hr = (const v4u*)(hin + (size_t)mm[t] * DM) + F.lane; const v4u* y0 = (const v4u*)(YM + (size_t)r0[t] * DM) + F.lane; const v4u* y1 = (const v4u*)(YM + (size_t)r1[t] * DM) + F.lane;
#pragma unroll
            for (int j = 0; j < 4; ++j) { ya[t][j] = y0[64 * j]; yb[t][j] = y1[64 * j]; hh[t][j] = hr[64 * j]; } }
#pragma unroll
        for (int t = 0; t < 2; ++t) {
            if (t == 1 && mb + NGW >= T) break;
            const int m = mm[t]; const float a0w = w0[t], a1w = w1[t];
            float s = 0.f; v4u* o = (v4u*)(hb + (size_t)m * DM) + F.lane; f32x4 keep[4][2];
#pragma unroll
            for (int j = 0; j < 4; ++j) { const v4u A = ya[t][j], B = yb[t][j], H = hh[t][j];
                f32x4 a, b;
                a[0] = pg8::bf_lo(H.x) + (a0w * pg8::bf_lo(A.x) + a1w * pg8::bf_lo(B.x)); a[1] = pg8::bf_hi(H.x) + (a0w * pg8::bf_hi(A.x) + a1w * pg8::bf_hi(B.x)); a[2] = pg8::bf_lo(H.y) + (a0w * pg8::bf_lo(A.y) + a1w * pg8::bf_lo(B.y)); a[3] = pg8::bf_hi(H.y) + (a0w * pg8::bf_hi(A.y) + a1w * pg8::bf_hi(B.y));
                b[0] = pg8::bf_lo(H.z) + (a0w * pg8::bf_lo(A.z) + a1w * pg8::bf_lo(B.z)); b[1] = pg8::bf_hi(H.z) + (a0w * pg8::bf_hi(A.z) + a1w * pg8::bf_hi(B.z)); b[2] = pg8::bf_lo(H.w) + (a0w * pg8::bf_lo(A.w) + a1w * pg8::bf_lo(B.w)); b[3] = pg8::bf_hi(H.w) + (a0w * pg8::bf_hi(A.w) + a1w * pg8::bf_hi(B.w));
                s += (a[0] * a[0] + a[1] * a[1]) + (a[2] * a[2] + a[3] * a[3]) + (b[0] * b[0] + b[1] * b[1]) + (b[2] * b[2] + b[3] * b[3]);
                v4u w; w.x = pk2(a[0], a[1]); w.y = pk2(a[2], a[3]); w.z = pk2(b[0], b[1]); w.w = pk2(b[2], b[3]); o[64 * j] = w; keep[j][0] = a; keep[j][1] = b; }
            s = wave_sum(s);
            const float rstd = 1.0f / sqrtf(s * (1.0f / DM) + RMS_EPS);
            if (F.lane == 0) rstd5[m] = rstd;
            if (h8) { const float xs = rstd * ASC_X; typedef unsigned u32x2 __attribute__((ext_vector_type(2)));
#pragma unroll
                for (int j = 0; j < 4; ++j) { u32x2 w; w.x = pg8::pk4_fp8(keep[j][0][0] * xs, keep[j][0][1] * xs, keep[j][0][2] * xs, keep[j][0][3] * xs); w.y = pg8::pk4_fp8(keep[j][1][0] * xs, keep[j][1][1] * xs, keep[j][1][2] * xs, keep[j][1][3] * xs);
                    *((u32x2*)(h8 + (size_t)m * DM) + 64 * j + F.lane) = w; } }
        }
    }
}

#ifndef MK_PER_PHASE
#define MK_PER_PHASE 0
#endif
constexpr int NPHASE = 19;
struct Args { const float* in[22]; float* out; unsigned char* ws; int ph_lo, ph_hi; };
static_assert(sizeof(Args) == 24 * 8 + 8, "Args has no padding");

__global__ void __launch_bounds__(NWAVES * 64, 2) yoco_fwd(Args args) {
    extern __shared__ __attribute__((aligned(16))) unsigned char lds[];
    Frame F;
    F.lds = (LAS unsigned char*)lds;
    F.MISC = (volatile LAS unsigned*)(F.lds + MISC_OFF);
    F.tab = (LAS float*)(F.lds + TAB_OFF);
    F.tid = threadIdx.x; F.lane = F.tid & 63; F.wave = __builtin_amdgcn_readfirstlane(F.tid >> 6);
    F.G = gridDim.x; { const int bx = blockIdx.x; F.vcu = (F.G % 8 == 0) ? (bx % 8) * (F.G / 8) + bx / 8 : bx; }
    unsigned char* ws = args.ws; F.ws = ws; F.out = args.out;
    F.ctl = (gu32*)(ws + WS_CTL);
    for (int u = F.tid; u < (LDS_BYTES - MISC_OFF) / 4; u += NWAVES * 64) ((LAS unsigned*)(F.lds + MISC_OFF))[u] = 0u;
    __syncthreads();
    XcdBarrier bar; bar.bar = (unsigned*)(F.ctl + CW_BAR); bar.x = 0; bar.st = nullptr;
    if (!MK_PER_PHASE) bar = xcd_barrier_post((unsigned*)(F.ctl + CW_BAR), F.MISC + 8);
    const int lo = args.ph_lo, hi = args.ph_hi;
#ifndef PHMASK
#define PHMASK 0xFFFFFFFFu
#endif
#ifndef XCD_LOCAL_SEAMS
#define XCD_LOCAL_SEAMS 1
#endif
#ifndef PROBE_DUP
#define PROBE_DUP 0u
#endif
#define REP(k) for (int rep_ = 0; rep_ < (((PROBE_DUP >> (k)) & 1u) ? 2 : 1); ++rep_)
#define IN(k) (((PHMASK >> (k)) & 1u) && lo <= (k) && (k) < hi)
#define SEAM(k) do { if (IN(k) && (IN((k) + 1) || IN((k) + 2) || IN((k) + 3))) xcd_barrier(bar); } while (0)
#define SEAM5 do { if (IN(5) && (IN(6) || IN(7) || IN(8))) xcd_barrier(bar, XCD_LOCAL_SEAMS != 0 && F.G * 32 == T && F.G % 8 == 0 && (((T / 256) * (2 * DFF / 256)) % F.G) % 8 == 0 && T / 256 == 32); } while (0)
#define SEAML(k) do { if (IN(k) && (IN((k) + 1) || IN((k) + 2) || IN((k) + 3))) xcd_barrier(bar, XCD_LOCAL_SEAMS != 0 && F.G * 32 == T); } while (0)
    constexpr int NPOS = 4;
    int npos = NPOS; asm volatile("" : "+s"(npos)); int cgrp = (((int)blockIdx.x >> 3) * NPOS) / ((int)gridDim.x >> 3);
#define HOSTB(slot) _Pragma("nounroll") for (int pos_ = 0; pos_ < npos; ++pos_) { int p_ = pos_; asm volatile("" : "+s"(p_)); \
        if (BGCVT > (slot) && p_ == cgrp) for (int r_ = 0; r_ < PROBE_CVTREP; ++r_) moe_cvt_slot(F, slot, BGCVT); if (p_ < NPOS - 1) {
#define HOSTE } }
#define CVT_AT(slot, atend) do { if (BGCVT > (slot) && ((cgrp & 1) != 0) == (atend)) for (int r_ = 0; r_ < PROBE_CVTREP; ++r_) moe_cvt_slot(F, slot, BGCVT); } while (0)
#define HOSTRANGE(S, upp) do { S.i0 = p_ * (upp); S.iend = p_ == NPOS - 2 ? (1 << 24) : (p_ + 1) * (upp); } while (0)
    const LAS float* tabc = (const LAS float*)F.tab;
    bf16* HB = (bf16*)(ws + WS_HB); bf16* HB2 = (bf16*)(ws + WS_HB2);
    float* rstd0 = (float*)(ws + WS_RSTD); float* rstd5 = rstd0 + 2 * T;
    float* SL1 = (float*)(ws + WS_SL1); float* SL2 = (float*)(ws + WS_SL2); float* SL3 = (float*)(ws + WS_SL3);
    int cid = (int)blockIdx.x;
    using pg8::Gemm; using pg8::StaticOrder; using pg8::GroupedOrder; using pg8::RsNone; using pg8::RsDirect; using pg8::RsSlots;

    if (IN(0)) REP(0) { if (rep_) { VM_WAIT(); __syncthreads(); } p0_prologue(F); } SEAM(0);
    bool xcc_dealt = false;
    if (XCD_LOCAL_SEAMS && !MK_PER_PHASE && F.G * 32 == T) {
        const unsigned uni = __builtin_amdgcn_readfirstlane(F.MISC[8 + 2]), rk = __builtin_amdgcn_readfirstlane(F.MISC[8 + 3]);
        if (uni) { xcc_dealt = true; cid = (int)(rk * 8u + bar.x); F.vcu = (int)(bar.x * (unsigned)(F.G / 8) + rk); cgrp = (int)(rk * NPOS) / (F.G / 8); }
    }
    if (IN(2)) REP(2) { if (rep_) { VM_WAIT(); __syncthreads(); } HOSTB(0)
        Gemm g{HB, (const bf16*)(ws + WS_WCI), T, 3 * DM, DM};
        StaticOrder<RsDirect> S; S.init(T, 3 * DM, F.G, cid); S.rs = RsDirect{rstd0, F.tab}; HOSTRANGE(S, 1);
        pg8::EpiPair<0, true> E{(bf16*)(ws + WS_U), DM, 16, (bf16*)(ws + WS_BG), DM, tabc, 1.0f, 1.0f};
        pg8::gemm_phase<pg8::EpiPair<0, true>, StaticOrder<RsDirect>, true, true>(F.lds + RING_OFF, g, S, E);
        HOSTE
    } SEAM(2);
    if (IN(3)) REP(3) { if (rep_) { VM_WAIT(); __syncthreads(); } p3_conv(F); } SEAML(3);
    if (IN(4)) REP(4) { if (rep_) { VM_WAIT(); __syncthreads(); }
        Gemm g{(const bf16*)(ws + WS_YB), (const bf16*)(ws + WS_WCO), T, DM, DM};
        StaticOrder<RsNone> S; S.init(T, DM, F.G, cid);
        pg8::EpiResid<0, true, false> E{arg_in(0), HB2, SL1, nullptr, tabc, FP8_FFN ? (unsigned char*)(ws + WS_H8) : nullptr, ASC_X, 1.0f};
        pg8::gemm_phase<pg8::EpiResid<0, true, false>, StaticOrder<RsNone>, true, true>(F.lds + RING_OFF, g, S, E);
    } SEAML(4);
    if (IN(5)) REP(5) { if (rep_) { VM_WAIT(); __syncthreads(); } HOSTB(1)
        Gemm g{FP8_FFN ? (const bf16*)(ws + WS_H8) : HB2, (const bf16*)(ws + WS_WGU), T, 2 * DFF, FP8_FFN ? DM / 2 : DM};
        StaticOrder<RsSlots> S; S.init(T, 2 * DFF, F.G, cid); S.rs = RsSlots{SL1, F.tab, FP8_FFN ? 1.0f / (ASC_X * WSC_GU) : 1.0f}; HOSTRANGE(S, 2);
        pg8::EpiPair<1, false, FP8_FFN> E{(bf16*)(ws + WS_ACT), DFF, 1 << 30, nullptr, 0, tabc, FP8_FFN ? ASC_ACT : 1.0f, 1.0f};
        pg8::gemm_phase<pg8::EpiPair<1, false, FP8_FFN>, StaticOrder<RsSlots>, true, true, FP8_FFN>(F.lds + RING_OFF, g, S, E);
        HOSTE
        { const int nwg5 = (T / 256) * (2 * DFF / 256), short_lo = nwg5 % F.G;
          if (short_lo == 0 || cid >= short_lo) {
            Gemm g2{(const bf16*)(ws + WS_PB), (const bf16*)(ws + WS_WPU), 2 * T, DM, PLE};
            pg8::EpiBf16S<false> E2{(bf16*)(ws + WS_E0), DM, 0, 0, tabc, 1.0f};
            if (F.G % 8 == 0 && short_lo % 8 == 0 && T / 256 == 32) {
                pg8::PanelOrder S2{cid % 8, (cid - short_lo) / 8, (F.G - short_lo) / 8, T / 256};
                pg8::gemm_phase<pg8::EpiBf16S<false>, pg8::PanelOrder, true, true>(F.lds + RING_OFF, g2, S2, E2);
            } else {
                const int rt2[NE] = {T / 256, T / 256, 0, 0, 0, 0, 0, 0};
                GroupedOrder<RsNone> S2; S2.init(rt2, DM / 256, short_lo ? F.G - short_lo : F.G, short_lo ? cid - short_lo : cid);
                pg8::gemm_phase<pg8::EpiBf16S<false>, GroupedOrder<RsNone>, true, true>(F.lds + RING_OFF, g2, S2, E2); } } }
    } SEAM5;
    if (IN(6)) {
        Gemm g{(const bf16*)(ws + WS_ACT), (const bf16*)(ws + WS_WFD), T, DM, FP8_FFN ? DFF / 2 : DFF};
        StaticOrder<RsNone> S; S.init(T, DM, F.G, cid);
        pg8::EpiResid<0, false, false> E{HB2, HB, SL2, nullptr, tabc, FP8_PLE0 ? (unsigned char*)(ws + WS_H8B) : nullptr, ASC_X, FP8_FFN ? 1.0f / (ASC_ACT * WSC_DN) : 1.0f};
        pg8::gemm_phase<pg8::EpiResid<0, false, false>, StaticOrder<RsNone>, true, true, FP8_FFN>(F.lds + RING_OFF, g, S, E);
    } SEAML(6);
    if (IN(7)) {
        Gemm g{FP8_PLE0 ? (const bf16*)(ws + WS_H8B) : HB, (const bf16*)(ws + WS_WPG), T, DM, FP8_PLE0 ? DM / 2 : DM};
        StaticOrder<RsSlots> S; S.init(T, DM, F.G, cid); S.rs = RsSlots{SL2, F.tab, FP8_PLE0 ? 1.0f / (ASC_X * WSC_GU) : 1.0f};
        pg8::EpiResid<1, false, false> E{HB, HB2, SL3, (const bf16*)(ws + WS_E0), tabc, FP8_QKV ? (unsigned char*)(ws + WS_H8) : nullptr, ASC_X, 1.0f};
        pg8::gemm_phase<pg8::EpiResid<1, false, false>, StaticOrder<RsSlots>, true, true, FP8_PLE0>(F.lds + RING_OFF, g, S, E);
    } SEAML(7);
    if (IN(8)) REP(8) { if (rep_) { VM_WAIT(); __syncthreads(); }
        Gemm g{FP8_QKV ? (const bf16*)(ws + WS_H8) : HB2, (const bf16*)(ws + WS_WQKV), T, 3 * DM, FP8_QKV ? DM / 2 : DM};
        StaticOrder<RsSlots> S; S.init(T, 3 * DM, F.G, cid); S.rs = RsSlots{SL3, F.tab, FP8_QKV ? 1.0f / (ASC_X * WSC_GU) : 1.0f};
        pg8::EpiQKV E{(bf16*)(ws + WS_Q), (bf16*)(ws + WS_K), (bf16*)(ws + WS_V), arg_in(13), arg_in(11), tabc, (LAS float*)(F.lds + TAB_OFF + 2048)};
        pg8::gemm_phase<pg8::EpiQKV, StaticOrder<RsSlots>, true, true, FP8_QKV>(F.lds + RING_OFF, g, S, E);
        p9_flogit(F, HB2, SL3);
    } SEAM(8);
    if (IN(11)) REP(11) { if (rep_) { VM_WAIT(); __syncthreads(); } CVT_AT(2, false);
        const fox::Ptrs P{(const fox::bf16*)(ws + WS_Q), (const fox::bf16*)(ws + WS_K), (const fox::bf16*)(ws + WS_V), (fox::bf16*)(ws + WS_O), (const float*)(ws + WS_LF)};
        const int total = NB * NH * 4;
        int L = F.vcu;
        if (L < total) {
            int pass = 0, par = 0; fox::BlockRef cur = fox::mk_ref(L, 0); fox::Seam S;
            fox::fox_prime(P, cur, (char*)lds + RING_OFF, S);
            for (;;) {
                const bool more_pass = pass == 0, more_item = L + F.G < total, last = !more_pass && !more_item;
                int Ln = L, passn = pass + 1; if (!more_pass) { passn = 0; Ln = more_item ? L + F.G : L; }
                const fox::BlockRef nxt = last ? cur : fox::mk_ref(Ln, passn);
                fox::fox_block(P, cur, nxt, par, (char*)lds + RING_OFF, S);
                if (last) break;
                cur = nxt; pass = passn; L = Ln; par ^= 1;
            }
        }
        VM_WAIT(); CVT_AT(2, true);
    } SEAM(11);
    if (IN(12)) {
        Gemm g{(const bf16*)(ws + WS_O), (const bf16*)(ws + WS_WO), T, DM, FP8_WO ? DM / 2 : DM};
        StaticOrder<RsNone> S; S.init(T, DM, F.G, cid);
        pg8::EpiResid<0, false, false> E{HB2, HB, nullptr, nullptr, tabc, nullptr, 1.0f, FP8_WO ? 1.0f / (16.0f * WSC_GU) : 1.0f};
        pg8::gemm_phase<pg8::EpiResid<0, false, false>, StaticOrder<RsNone>, true, true, FP8_WO>(F.lds + RING_OFF, g, S, E);
    } SEAML(12);
    if (IN(13)) REP(13) { if (rep_) { VM_WAIT(); __syncthreads(); } p13_route(F); } SEAM(13);
    if (IN(14)) REP(14) { if (rep_) { VM_WAIT(); __syncthreads(); } p14_gather(F, HB); } SEAM(14);
    int rts[NE];
    if (IN(15) || IN(16)) {
        const int* rp = (const int*)(ws + WS_ROUTE + 300000);
#pragma unroll
        for (int e = 0; e < NE; ++e) rts[e] = __builtin_amdgcn_readfirstlane((int)__hip_atomic_load((unsigned*)rp + e, RLX_AGENT));
    }
    if (IN(15)) REP(15) { if (rep_) { VM_WAIT(); __syncthreads(); } HOSTB(3)
        Gemm g{(const bf16*)(ws + WS_XG), (const bf16*)(ws + WS_WMGU), MAXROWS, 2 * DFE, DM / 2};
        GroupedOrder<RsNone> S; S.init(rts, 2 * DFE / 256, F.G, cid);
        { const int upp = ((S.nwg + F.G - 1) / F.G + NPOS - 2) / (NPOS - 1); HOSTRANGE(S, upp); }
        pg8::EpiPair<1, false, true, false> E{(bf16*)(ws + WS_ACTM), DFE, 1 << 30, nullptr, 0, tabc, ASC_ACT, 1.0f / (ASC_X * WSC_GU)};
        pg8::gemm_phase<pg8::EpiPair<1, false, true, false>, GroupedOrder<RsNone>, true, true, true>(F.lds + RING_OFF, g, S, E);
        HOSTE
    } SEAM(15);
    if (IN(16)) REP(16) { if (rep_) { VM_WAIT(); __syncthreads(); }
        Gemm g{(const bf16*)(ws + WS_ACTM), (const bf16*)(ws + WS_WMD), MAXROWS, DM, DFE / 2};
        GroupedOrder<RsNone, true> S; S.init(rts, DM / 256, F.G, cid);
        const int nwg = S.nwg, nmain = (nwg / F.G) * F.G, R = nwg - nmain;
        const int Ssp = (R == 0) ? 0 : (R * 14 <= F.G ? 14 : R * 7 <= F.G ? 7 : R * 4 <= F.G ? 4 : R * 2 <= F.G ? 2 : 1);
        S.nlim = nmain;
        constexpr float CS16 = 1.0f / (ASC_ACT * WSC_DN);
        pg8::EpiBf16S<false> E{(bf16*)(ws + WS_YM), DM, 0, 0, tabc, CS16};
        pg8::gemm_phase<pg8::EpiBf16S<false>, GroupedOrder<RsNone, true>, true, true, true>(F.lds + RING_OFF, g, S, E);
        const bool pl = (R % 8 == 0) && (F.G % 8 == 0);
        const int prk = cid >> 3, pxc = cid & 7, prr = pl ? prk / (Ssp ? Ssp : 1) : 0;
        const bool mine = Ssp && (pl ? prr < R / 8 : cid < R * Ssp);
        if (mine) {
            const int ru = pl ? prr * 8 + pxc : cid / Ssp, sl = pl ? prk - prr * Ssp : cid - ru * Ssp, Ks = (DFE / 2) / Ssp, pid = ru * Ssp + sl;
            pg8::OneUnit O1; S.decode(nmain + ru, O1.u); O1.u.par = 0;
            bf16* YP = (bf16*)(ws + WS_YP) + (size_t)pid * 65536;
            Gemm g2{(const bf16*)(ws + WS_ACTM) + (size_t)sl * Ks, (const bf16*)(ws + WS_WMD) + (size_t)sl * Ks, MAXROWS, DM, Ks, DFE / 2};
            pg8::EpiSlab E2{YP, CS16};
            pg8::gemm_phase<pg8::EpiSlab, pg8::OneUnit, true, true, true>(F.lds + RING_OFF, g2, O1, E2);
            unsigned* cnt = (unsigned*)(F.ctl + CW_SPLIT) + 16 * ru;
            VM_WAIT(); __syncthreads();
            if (F.tid == 0) {
                if (!(pl && xcc_dealt)) { __builtin_amdgcn_fence(__ATOMIC_RELEASE, "agent"); asm volatile("s_waitcnt vmcnt(0)" ::: "memory"); }
                (void)__hip_atomic_fetch_add(cnt, 1u, RLX_AGENT);
                unsigned sp = 0; while (__hip_atomic_load(cnt, RLX_AGENT) < (unsigned)Ssp) { __builtin_amdgcn_s_sleep(2); if (++sp > (1u << 22)) break; }
                __builtin_amdgcn_fence(__ATOMIC_ACQUIRE, "agent"); asm volatile("s_waitcnt vmcnt(0)" ::: "memory");
            }
            __syncthreads();
            const int r0 = (256 * sl) / Ssp, r1 = (256 * (sl + 1)) / Ssp;
            const bf16* Y0 = (const bf16*)(ws + WS_YP) + (size_t)(ru * Ssp) * 65536; bf16* YM = (bf16*)(ws + WS_YM);
            for (int idx = F.tid; idx < (r1 - r0) * 32; idx += NWAVES * 64) { const int row = r0 + (idx >> 5), ch = idx & 31; float acc8[8];
#pragma unroll
                for (int q = 0; q < 8; ++q) acc8[q] = 0.f;
                for (int p = 0; p < Ssp; ++p) { const v4u a = *(const v4u*)(Y0 + (size_t)p * 65536 + row * 256 + ch * 8);
                    acc8[0] += pg8::bf_lo(a.x); acc8[1] += pg8::bf_hi(a.x); acc8[2] += pg8::bf_lo(a.y); acc8[3] += pg8::bf_hi(a.y); acc8[4] += pg8::bf_lo(a.z); acc8[5] += pg8::bf_hi(a.z); acc8[6] += pg8::bf_lo(a.w); acc8[7] += pg8::bf_hi(a.w); }
                v4u o; o.x = pk2(acc8[0], acc8[1]); o.y = pk2(acc8[2], acc8[3]); o.z = pk2(acc8[4], acc8[5]); o.w = pk2(acc8[6], acc8[7]);
                *(v4u*)(YM + (size_t)(O1.u.pm * 256 + row) * DM + O1.u.aux * 256 + ch * 8) = o; }
        }
    } SEAM(16);
    if (IN(17)) { p17_combine(F, HB, HB2, FP8_PLE1 ? (unsigned char*)(ws + WS_H8) : nullptr); } SEAML(17);
    if (IN(18)) {
        if (FP8_PLE1) {
            Gemm g{(const bf16*)(ws + WS_H8), (const bf16*)(ws + WS_WPG) + (size_t)DM * DM, T, DM, DM / 2};
            StaticOrder<RsNone> S; S.init(T, DM, F.G, cid);
            pg8::EpiResid<1, false, true, true> E{HB2, F.out, nullptr, (const bf16*)(ws + WS_E1), tabc, nullptr, 1.0f, 1.0f / (ASC_X * WSC_GU)};
            pg8::gemm_phase<pg8::EpiResid<1, false, true, true>, StaticOrder<RsNone>, true, true, true>(F.lds + RING_OFF, g, S, E);
        } else {
            Gemm g{HB2, (const bf16*)(ws + WS_WPG) + (size_t)DM * DM, T, DM, DM};
            StaticOrder<RsDirect> S; S.init(T, DM, F.G, cid); S.rs = RsDirect{rstd5, F.tab};
            pg8::EpiResid<1, false, true> E{HB2, F.out, nullptr, (const bf16*)(ws + WS_E1), tabc, nullptr, 1.0f, 1.0f};
            pg8::gemm_phase<pg8::EpiResid<1, false, true>, StaticOrder<RsDirect>, true, true>(F.lds + RING_OFF, g, S, E);
        }
    }
#undef IN
#undef SEAM
}

extern "C" void kernel_launch(void* const* d_in, const int* in_sizes, int n_in, void* d_out, int out_size, void* d_ws, size_t ws_size, hipStream_t stream) {
    static int grid = 0;
    if (grid == 0) {
        if (n_in != 22 || out_size != T * DM || ws_size < WS_END) { fprintf(stderr, "kernel_launch: unexpected shapes (n_in %d out %d ws %zu need %zu)\n", n_in, out_size, ws_size, (size_t)WS_END); grid = -1; return; }
        int dev = 0, cus = 0, per_cu = 0;
        if (hipGetDevice(&dev) != hipSuccess || hipDeviceGetAttribute(&cus, hipDeviceAttributeMultiprocessorCount, dev) != hipSuccess) { grid = -1; return; }
        if (hipFuncSetAttribute((const void*)yoco_fwd, hipFuncAttributeMaxDynamicSharedMemorySize, LDS_BYTES) != hipSuccess) { fprintf(stderr, "kernel_launch: hipFuncSetAttribute failed\n"); grid = -1; return; }
        if (hipOccupancyMaxActiveBlocksPerMultiprocessor(&per_cu, (const void*)yoco_fwd, NWAVES * 64, LDS_BYTES) != hipSuccess || per_cu < 1) { fprintf(stderr, "kernel_launch: occupancy query says %d\n", per_cu); }
        (void)hipGetLastError();
        grid = cus;
    }
    if (grid < 0) return;
    (void)hipMemsetAsync((char*)d_ws + WS_CTL, 0, CTL_ZERO_BYTES, stream);
    Args a{};
    for (int i = 0; i < 22; ++i) a.in[i] = (const float*)d_in[i];
    a.out = (float*)d_out; a.ws = (unsigned char*)d_ws;
#if MK_PER_PHASE
    for (int p = 0; p < NPHASE; ++p) { a.ph_lo = p; a.ph_hi = p + 1; hipLaunchKernelGGL(yoco_fwd, dim3(grid), dim3(NWAVES * 64), LDS_BYTES, stream, a); }
#else
    a.ph_lo = 0; a.ph_hi = NPHASE;
    hipLaunchKernelGGL(yoco_fwd, dim3(grid), dim3(NWAVES * 64), LDS_BYTES, stream, a);
#endif
    const hipError_t le = hipPeekAtLastError();
    if (le != hipSuccess) fprintf(stderr, "kernel_launch: launch failed: %s\n", hipGetErrorName(le));
}
```
